# Optimizing an MI355X kernel written in HIP

```python
import jax, jax.numpy as jnp
from jax import lax
import numpy as np

D_MODEL = 2048
BATCH = 8
SEQ = 2048
DEPTH = 1

RET_HEADS = 4
RET_HEAD_DIM = 256
RET_WIDTH = RET_HEADS * RET_HEAD_DIM
RET_CHUNK = 128
RET_ROPE_THETA = 10000.0
MOBA_HEADS = 8
MOBA_HEAD_DIM = 128
MOBA_WIDTH = MOBA_HEADS * MOBA_HEAD_DIM
MOBA_BLOCK = 256
MOBA_TOPK = 3
MOBA_Q_CHUNK = 64
ROPE_THETA = 500000.0
ROT_DIM = MOBA_HEAD_DIM // 4
D_FF = 5632
CONV_WIDTH = 3
EPS = 1e-6
IN_SIZES = (RET_WIDTH, RET_WIDTH, RET_WIDTH, RET_WIDTH,
            MOBA_WIDTH, MOBA_WIDTH, MOBA_WIDTH,
            D_MODEL, D_MODEL)
IN_TOTAL = sum(IN_SIZES)

kernel_name = "hybrid_retention_moba_convffn"


def rmsnorm(x, w):
    xf = x.astype(jnp.float32)
    y = xf * lax.rsqrt(jnp.mean(xf * xf, axis=-1, keepdims=True) + EPS)
    return (y * w.astype(jnp.float32)).astype(x.dtype)


def rotary(x, rot_dim, theta):
    S = x.shape[1]
    pos = jnp.arange(S, dtype=jnp.float32)
    inv_freq = jnp.asarray(theta, jnp.float32) ** (-jnp.arange(0, rot_dim, 2, dtype=jnp.float32) / rot_dim)
    ang = pos[:, None] * inv_freq[None, :]
    cos = jnp.cos(ang)[None, :, None, :]
    sin = jnp.sin(ang)[None, :, None, :]
    xr = x[..., :rot_dim].astype(jnp.float32)
    x1, x2 = jnp.split(xr, 2, axis=-1)
    rot = jnp.concatenate([x1 * cos - x2 * sin, x2 * cos + x1 * sin], axis=-1).astype(x.dtype)
    return jnp.concatenate([rot, x[..., rot_dim:]], axis=-1)


def retention(q, k, v):
    B, S, H, dk = q.shape
    dv = v.shape[-1]
    C = RET_CHUNK
    N = S // C
    q = q.astype(jnp.float32)
    k = k.astype(jnp.float32) * (dk ** -0.5)
    v = v.astype(jnp.float32)
    log_g = jnp.log1p(-jnp.exp2(-5.0 - jnp.arange(H, dtype=jnp.float32)))
    i = jnp.arange(C, dtype=jnp.float32)
    diff = i[:, None] - i[None, :]
    causal = diff >= 0
    decay = jnp.where(causal[None], jnp.exp(log_g[:, None, None] * jnp.where(causal, diff, 0.0)[None]), 0.0)
    xi = jnp.exp(log_g[:, None] * (i[None, :] + 1.0))
    zeta = jnp.exp(log_g[:, None] * (C - 1.0 - i[None, :]))
    g_chunk = jnp.exp(log_g * C)

    def to_chunks(t):
        return t.reshape(B, N, C, H, t.shape[-1]).transpose(1, 0, 3, 2, 4)

    def step(state, xs):
        qc, kc, vc = xs
        scores = jnp.einsum('bhqd,bhkd->bhqk', qc, kc) * decay[None]
        inner = jnp.einsum('bhqk,bhkd->bhqd', scores, vc)
        cross = jnp.einsum('bhqd,bhde->bhqe', qc, state) * xi[None, :, :, None]
        new_state = state * g_chunk[None, :, None, None] + jnp.einsum(
            'bhkd,bhke->bhde', kc * zeta[None, :, :, None], vc)
        return new_state, inner + cross

    init = jnp.zeros((B, H, dk, dv), jnp.float32)
    _, out = lax.scan(step, init, (to_chunks(q), to_chunks(k), to_chunks(v)))
    return out.transpose(1, 0, 3, 2, 4).reshape(B, S, H, dv)


def moba_attention(q, k, v):
    B, S, H, d = q.shape
    dtype = q.dtype
    BS = MOBA_BLOCK
    Cq = MOBA_Q_CHUNK
    NB = -(-S // BS)
    S_pad = NB * BS
    NQ = S // Cq
    topk = min(MOBA_TOPK, NB)
    scale = d ** -0.5
    qh = q.transpose(0, 2, 1, 3)
    pad = ((0, 0), (0, 0), (0, S_pad - S), (0, 0))
    kb = jnp.pad(k.transpose(0, 2, 1, 3), pad).reshape(B, H, NB, BS, d)
    vb = jnp.pad(v.transpose(0, 2, 1, 3), pad).reshape(B, H, NB, BS, d)
    kmean = jnp.mean(kb.astype(jnp.float32), axis=3)
    q_all = qh.reshape(B, H, NQ, Cq, d).transpose(0, 2, 1, 3, 4).reshape(B * NQ, H, Cq, d)
    b_idx = jnp.repeat(jnp.arange(B, dtype=jnp.int32), NQ)
    n_idx = jnp.tile(jnp.arange(NQ, dtype=jnp.int32), B)
    hh = jnp.arange(H)[:, None, None]

    def step(args):
        qc, b, n = args
        kb_b, vb_b, km_b = kb[b], vb[b], kmean[b]
        q0 = n * Cq
        cb = q0 // BS
        qpos = q0 + jnp.arange(Cq)
        bscore = jnp.einsum('hqd,hnd->hqn', qc.astype(jnp.float32), km_b)
        past = jnp.arange(NB) < cb
        bscore = jnp.where(past[None, None, :], bscore, -jnp.inf)
        _, idx = lax.top_k(bscore, topk)
        valid = idx < cb
        k_sel = kb_b[hh, idx]
        v_sel = vb_b[hh, idx]
        s_sel = jnp.einsum('hqd,hqnkd->hqnk', qc, k_sel, preferred_element_type=jnp.float32) * scale
        s_sel = jnp.where(valid[..., None], s_sel, -jnp.inf).reshape(H, Cq, topk * BS)
        k_own = lax.dynamic_index_in_dim(kb_b, cb, axis=1, keepdims=False)
        v_own = lax.dynamic_index_in_dim(vb_b, cb, axis=1, keepdims=False)
        s_own = jnp.einsum('hqd,hkd->hqk', qc, k_own, preferred_element_type=jnp.float32) * scale
        kpos = cb * BS + jnp.arange(BS)
        s_own = jnp.where((kpos[None, :] <= qpos[:, None])[None], s_own, -jnp.inf)
        p = jax.nn.softmax(jnp.concatenate([s_sel, s_own], axis=-1), axis=-1).astype(dtype)
        p_sel = p[..., :topk * BS].reshape(H, Cq, topk, BS)
        p_own = p[..., topk * BS:]
        o = jnp.einsum('hqnk,hqnkd->hqd', p_sel, v_sel) + jnp.einsum('hqk,hkd->hqd', p_own, v_own)
        return o.astype(dtype)

    out = lax.map(step, (q_all, b_idx, n_idx))
    return out.reshape(B, NQ, H, Cq, d).transpose(0, 1, 3, 2, 4).reshape(B, S, H * d)


def causal_dwconv(u, w, b):
    S = u.shape[1]
    up = jnp.pad(u, ((0, 0), (CONV_WIDTH - 1, 0), (0, 0)))
    y = b
    for j in range(CONV_WIDTH):
        y = y + w[j] * up[:, j:j + S]
    return y


def setup_inputs(seed: int = 0) -> dict:
    key = jax.random.key(seed)
    ks = jax.random.split(key, 14)
    f32 = jnp.float32

    def normal(k, shape, scale):
        return jax.random.normal(k, shape, f32) * scale

    def gain(k, shape):
        return 1.0 + 0.05 * jax.random.normal(k, shape, f32)

    return {
        "x": jax.random.normal(ks[0], (BATCH, SEQ, D_MODEL), f32),
        "attn_norm_w": gain(ks[1], (DEPTH, D_MODEL)),
        "w_in": normal(ks[2], (DEPTH, D_MODEL, IN_TOTAL), D_MODEL ** -0.5),
        "ret_norm_w": gain(ks[3], (DEPTH, RET_WIDTH)),
        "w_ret_up": normal(ks[4], (DEPTH, RET_WIDTH, D_MODEL), RET_WIDTH ** -0.5),
        "w_moba_up": normal(ks[5], (DEPTH, MOBA_WIDTH, D_MODEL), MOBA_WIDTH ** -0.5),
        "w_out": normal(ks[6], (DEPTH, D_MODEL, D_MODEL), D_MODEL ** -0.5),
        "ffn_norm_w": gain(ks[7], (DEPTH, D_MODEL)),
        "w_ffn_up": normal(ks[8], (DEPTH, D_MODEL, 2 * D_FF), D_MODEL ** -0.5),
        "conv_w": normal(ks[9], (DEPTH, CONV_WIDTH, 2 * D_FF), CONV_WIDTH ** -0.5),
        "conv_b": normal(ks[10], (DEPTH, 2 * D_FF), 0.01),
        "w_ffn_down": normal(ks[11], (DEPTH, D_FF, D_MODEL), D_FF ** -0.5),
        "final_norm_w": gain(ks[12], (D_MODEL,)),
    }


def reference(x, attn_norm_w, w_in, ret_norm_w, w_ret_up, w_moba_up, w_out,
              ffn_norm_w, w_ffn_up, conv_w, conv_b, w_ffn_down, final_norm_w):
    B, S, _ = x.shape
    split_at = [int(s) for s in np.cumsum(IN_SIZES)[:-1]]
    for l in range(DEPTH):
        h = rmsnorm(x, attn_norm_w[l])
        proj = h @ w_in[l]
        rq, rk, rv, rg, mq, mk, mv, g_ret, g_moba = jnp.split(proj, split_at, axis=-1)
        rq = rotary(rq.reshape(B, S, RET_HEADS, RET_HEAD_DIM), RET_HEAD_DIM, RET_ROPE_THETA)
        rk = rotary(rk.reshape(B, S, RET_HEADS, RET_HEAD_DIM), RET_HEAD_DIM, RET_ROPE_THETA)
        rv = rv.reshape(B, S, RET_HEADS, RET_HEAD_DIM)
        o_ret = retention(rq, rk, rv)
        o_ret = o_ret * lax.rsqrt(jnp.mean(o_ret * o_ret, axis=-1, keepdims=True) + EPS)
        o_ret = o_ret.reshape(B, S, RET_WIDTH).astype(x.dtype) * ret_norm_w[l]
        o_ret = jax.nn.silu(rg) * o_ret
        mq = rotary(mq.reshape(B, S, MOBA_HEADS, MOBA_HEAD_DIM), ROT_DIM, ROPE_THETA)
        mk = rotary(mk.reshape(B, S, MOBA_HEADS, MOBA_HEAD_DIM), ROT_DIM, ROPE_THETA)
        mv = mv.reshape(B, S, MOBA_HEADS, MOBA_HEAD_DIM)
        o_moba = moba_attention(mq, mk, mv)
        merged = jax.nn.sigmoid(g_ret) * (o_ret @ w_ret_up[l]) + jax.nn.sigmoid(g_moba) * (o_moba @ w_moba_up[l])
        x = x + merged @ w_out[l]
        h2 = rmsnorm(x, ffn_norm_w[l])
        up = causal_dwconv(h2 @ w_ffn_up[l], conv_w[l], conv_b[l])
        a, b = jnp.split(up, 2, axis=-1)
        x = x + (jax.nn.silu(a) * b) @ w_ffn_down[l]
    return rmsnorm(x, final_norm_w)
```

```cpp
#include <hip/hip_runtime.h>
#include <hip/hip_cooperative_groups.h>
#include <cstdio>
#include <cstdint>
#include <type_traits>
namespace cg = cooperative_groups;
#ifndef GEMM_ALIGN
#define GEMM_ALIGN true
#endif
#ifndef GEMM_SP2
#define GEMM_SP2 true
#endif
#ifndef FUSED_FFN
#define FUSED_FFN 1
#endif
namespace pg8 {
#define PG8_LAS __attribute__((address_space(3)))
typedef unsigned short bf16_t;
typedef short bf16x8 __attribute__((ext_vector_type(8)));
typedef float f32x4 __attribute__((ext_vector_type(4)));
typedef unsigned u32x4 __attribute__((ext_vector_type(4)));
constexpr int BM = 256, BK = 64, HALF = 128, HTB = HALF * BK * 2  , STAGE_BYTES = 8 * HTB, NXCD = 8, WGM = 8;

__host__ __device__ __forceinline__ int lds_byte(int r, int c) { const int st = (r >> 4) * 2 + (c >> 5), rr = r & 15, cc = c & 31, ob = rr * 64 + cc * 2; return st * 1024 + (ob ^ (((ob >> 9) & 1) << 5)); }
__host__ __device__ __forceinline__ void stage_rc(int b, int& R, int& C) { const int st = b / 1024, sb = b % 1024, swz = sb ^ (((sb >> 9) & 1) << 5); R = (st >> 1) * 16 + swz / 64; C = (st & 1) * 32 + (swz % 64) / 2; }
__host__ __device__ __forceinline__ int perm32(int rho) { const int n = rho >> 4, i = rho & 15; return 8 * (i >> 2) + 4 * n + (i & 3); }

struct Unit { int pm, pn; };
struct Gemm { const bf16_t* A; const bf16_t* Bt; int M, N, K; };

struct StaticOrder {
    int nM, nN, nwg, G, c;
    __host__ __device__ void init(int M, int N, int G_, int c_) { nM = M / BM; nN = N / BM; nwg = nM * nN; G = G_; c = c_; }
    __host__ __device__ bool next(int i, Unit& u) const {
        const long L = (long)i * G + c; if (L >= nwg) return false;
        int wgid = (int)L; { const int q = nwg / NXCD, r = nwg % NXCD, xcd = wgid % NXCD, off = wgid / NXCD; wgid = (xcd < r ? xcd * (q + 1) : r * (q + 1) + (xcd - r) * q) + off; }
        const int nig = WGM * nN, gid = wgid / nig, fm = gid * WGM, gsz = (nM - fm) < WGM ? (nM - fm) : WGM;
        u.pm = fm + ((wgid % nig) % gsz); u.pn = (wgid % nig) / gsz; return true;
    }
    __device__ __forceinline__ void a_ready(const Unit&) const {}
    __device__ __forceinline__ void done(const Unit&) const {}
};

__device__ __forceinline__ unsigned cvt_pk_bf16(float lo, float hi) { unsigned r; asm volatile("v_cvt_pk_bf16_f32 %0, %1, %2" : "=v"(r) : "v"(lo), "v"(hi)); return r; }
template <class E, class = void> struct epi_has_carry : std::false_type {};
template <class E> struct epi_has_carry<E, std::void_t<decltype(E::CARRY)>> : std::true_type {};
template <class Epi, class Sched, bool ALIGN_EPI = false, bool SP2 = false>
__device__ __forceinline__ void gemm_phase(PG8_LAS unsigned char* lds, const Gemm g, const Sched& S, const Epi& E) {
    int tid_ = threadIdx.x; asm volatile("" : "+v"(tid_));
    const int tid = tid_, wid = __builtin_amdgcn_readfirstlane(tid >> 6), lane = tid & 63, wr = wid >> 2, wc = wid & 3, fr = lane & 15, fq = lane >> 4;
    const int K = g.K, nt = K / BK;
    unsigned voffA[2], voffB[2];
#pragma unroll
    for (int i = 0; i < 2; ++i) { int R, C; stage_rc(tid * 16 + i * 8192, R, C); const int Rb = Epi::PERM ? ((R & ~31) + perm32(R & 31)) : R;
        voffA[i] = (unsigned)(R * K + C) * 2u; voffB[i] = (unsigned)(Rb * K + C) * 2u; }
    const size_t kstep = (size_t)(BK * 2);
    const size_t hstep = (size_t)HALF * K * 2;
    const size_t tstep = 2 * hstep;
    const unsigned ldsw = (unsigned)wid * 1024u;
    const int aoff = lds_byte(wr * 64 + fr, fq * 8), boff = lds_byte(wc * 32 + fr, fq * 8);
#define PG8_SA(b, h) (((b) * 2 + (h)) * HTB)
#define PG8_SB(b, h) ((4 + (b) * 2 + (h)) * HTB)
#define PG8_STAGE(bufoff, gbase, voff) do { _Pragma("unroll") for (int _i = 0; _i < 2; ++_i) \
        __builtin_amdgcn_global_load_lds((const unsigned*)((const char*)(gbase) + (voff)[_i]), (PG8_LAS unsigned*)(lds + (bufoff) + ldsw + _i * 8192), 16, 0, 0); } while (0)
#define PG8_LDA(dst, b, h) do { _Pragma("unroll") for (int m = 0; m < 4; ++m) _Pragma("unroll") for (int k = 0; k < 2; ++k) dst[m][k] = *(const PG8_LAS bf16x8*)(lds + PG8_SA(b, h) + aoff + m * 2048 + k * 1024); } while (0)
#define PG8_LDB(dst, b, h) do { _Pragma("unroll") for (int n = 0; n < 2; ++n) _Pragma("unroll") for (int k = 0; k < 2; ++k) dst[n][k] = *(const PG8_LAS bf16x8*)(lds + PG8_SB(b, h) + boff + n * 2048 + k * 1024); } while (0)
#define PG8_MMA(ai, bj, At, Bt) do { __builtin_amdgcn_s_setprio(1); _Pragma("unroll") for (int m = 0; m < 4; ++m) _Pragma("unroll") for (int n = 0; n < 2; ++n) _Pragma("unroll") for (int k = 0; k < 2; ++k) \
        acc[ai][bj][m][n] = __builtin_amdgcn_mfma_f32_16x16x32_bf16(Bt[n][k], At[m][k], acc[ai][bj][m][n], 0, 0, 0); __builtin_amdgcn_s_setprio(0); } while (0)
#define PG8_WAIT_V(n) asm volatile("s_waitcnt vmcnt(" #n ")" ::: "memory")
#define PG8_WAIT_L(n) asm volatile("s_waitcnt lgkmcnt(" #n ")" ::: "memory")
#define PG8_BAR __builtin_amdgcn_s_barrier()
#define PG8_SCHED __builtin_amdgcn_sched_barrier(0)
    Unit cur, nxt; int ui = 0;
    if (!S.next(0, cur)) return;
    f32x4 acc[2][2][4][2];
#pragma unroll
    for (int a = 0; a < 2; ++a)
#pragma unroll
        for (int b = 0; b < 2; ++b)
#pragma unroll
            for (int m = 0; m < 4; ++m)
#pragma unroll
                for (int n = 0; n < 2; ++n) acc[a][b][m][n] = (f32x4){0.f, 0.f, 0.f, 0.f};
    bf16x8 At[4][2], B0[2][2], B1[2][2];
    const char* cA = (const char*)g.A + (size_t)cur.pm * tstep; const char* cB = (const char*)g.Bt + (size_t)cur.pn * tstep;
    S.a_ready(cur);
    if constexpr (SP2) {
        PG8_STAGE(PG8_SB(0, 0), cB, voffB); PG8_STAGE(PG8_SB(0, 1), cB + hstep, voffB); PG8_STAGE(PG8_SA(0, 0), cA, voffA); PG8_STAGE(PG8_SA(0, 1), cA + hstep, voffA);
        if (wr == 1) PG8_BAR;
        PG8_WAIT_V(2); PG8_BAR;
        PG8_STAGE(PG8_SB(1, 0), cB + kstep, voffB); PG8_STAGE(PG8_SA(1, 0), cA + kstep, voffA); PG8_STAGE(PG8_SB(1, 1), cB + hstep + kstep, voffB);
        PG8_WAIT_V(6); PG8_BAR;
    } else {
        PG8_STAGE(PG8_SB(0, 0), cB, voffB); PG8_STAGE(PG8_SA(0, 0), cA, voffA); PG8_STAGE(PG8_SB(0, 1), cB + hstep, voffB); PG8_STAGE(PG8_SA(0, 1), cA + hstep, voffA);
        if (wr == 1) PG8_BAR;
        PG8_WAIT_V(4); PG8_BAR;
        PG8_STAGE(PG8_SB(1, 0), cB + kstep, voffB); PG8_STAGE(PG8_SA(1, 0), cA + kstep, voffA); PG8_STAGE(PG8_SB(1, 1), cB + hstep + kstep, voffB);
        PG8_WAIT_V(6); PG8_BAR;
    }
    for (;;) {
        const bool has_next = S.next(ui + 1, nxt);
        const char* nA = has_next ? (const char*)g.A + (size_t)nxt.pm * tstep : cA; const char* nB = has_next ? (const char*)g.Bt + (size_t)nxt.pn * tstep : cB;
        for (int t = 0; t < nt; t += 2) {
            const bool last = (t == nt - 2);
            const char* a1 = cA + (size_t)(t + 1) * kstep;
            const char* a2 = last ? nA : cA + (size_t)(t + 2) * kstep; const char* b2 = last ? nB : cB + (size_t)(t + 2) * kstep;
            const char* a3 = a2 + kstep; const char* b3 = b2 + kstep;
            if (last && has_next) S.a_ready(nxt);
            if constexpr (SP2) {
            PG8_LDB(B0, 0, 0); PG8_LDB(B1, 0, 1); PG8_SCHED; PG8_LDA(At, 0, 0); PG8_STAGE(PG8_SA(1, 1), a1 + hstep, voffA);
            PG8_WAIT_V(8); PG8_WAIT_L(0); PG8_BAR; PG8_MMA(0, 0, At, B0); PG8_MMA(0, 1, At, B1); PG8_BAR; PG8_SCHED;
            PG8_LDA(At, 0, 1); PG8_STAGE(PG8_SB(0, 0), b2, voffB); PG8_STAGE(PG8_SB(0, 1), b2 + hstep, voffB); PG8_STAGE(PG8_SA(0, 0), a2, voffA);
            PG8_WAIT_V(8); PG8_WAIT_L(0); PG8_BAR; PG8_MMA(1, 0, At, B0); PG8_MMA(1, 1, At, B1); PG8_BAR; PG8_SCHED;
            PG8_LDB(B0, 1, 0); PG8_LDB(B1, 1, 1); PG8_SCHED; PG8_LDA(At, 1, 0); PG8_STAGE(PG8_SA(0, 1), a2 + hstep, voffA);
            PG8_WAIT_V(8); PG8_WAIT_L(0); PG8_BAR; PG8_MMA(0, 0, At, B0); PG8_MMA(0, 1, At, B1); PG8_BAR; PG8_SCHED;
            PG8_LDA(At, 1, 1); PG8_STAGE(PG8_SB(1, 0), b3, voffB); PG8_STAGE(PG8_SB(1, 1), b3 + hstep, voffB); PG8_STAGE(PG8_SA(1, 0), a3, voffA);
            PG8_WAIT_V(8); PG8_WAIT_L(0); PG8_BAR; PG8_MMA(1, 0, At, B0); PG8_MMA(1, 1, At, B1); PG8_BAR; PG8_SCHED;
            } else {
            PG8_LDB(B0, 0, 0); PG8_SCHED; PG8_LDA(At, 0, 0); PG8_STAGE(PG8_SA(1, 1), a1 + hstep, voffA);
            PG8_WAIT_L(8); PG8_BAR; PG8_WAIT_L(0); PG8_MMA(0, 0, At, B0); PG8_BAR; PG8_SCHED;
            PG8_LDB(B1, 0, 1); PG8_STAGE(PG8_SB(0, 0), b2, voffB);
            PG8_BAR; PG8_WAIT_L(0); PG8_MMA(0, 1, At, B1); PG8_BAR;
            PG8_LDA(At, 0, 1); PG8_STAGE(PG8_SA(0, 0), a2, voffA);
            PG8_BAR; PG8_WAIT_L(0); PG8_MMA(1, 0, At, B0); PG8_BAR; PG8_SCHED;
            PG8_STAGE(PG8_SB(0, 1), b2 + hstep, voffB);
            PG8_WAIT_V(6); PG8_BAR; PG8_MMA(1, 1, At, B1); PG8_BAR;
            PG8_LDB(B0, 1, 0); PG8_SCHED; PG8_LDA(At, 1, 0); PG8_STAGE(PG8_SA(0, 1), a2 + hstep, voffA);
            PG8_WAIT_L(8); PG8_BAR; PG8_WAIT_L(0); PG8_MMA(0, 0, At, B0); PG8_BAR; PG8_SCHED;
            PG8_LDB(B1, 1, 1); PG8_STAGE(PG8_SB(1, 0), b3, voffB);
            PG8_BAR; PG8_WAIT_L(0); PG8_MMA(0, 1, At, B1); PG8_BAR;
            PG8_LDA(At, 1, 1); PG8_STAGE(PG8_SA(1, 0), a3, voffA);
            PG8_BAR; PG8_WAIT_L(0); PG8_MMA(1, 0, At, B0); PG8_BAR; PG8_SCHED;
            PG8_STAGE(PG8_SB(1, 1), b3 + hstep, voffB);
            PG8_WAIT_V(6); PG8_BAR; PG8_MMA(1, 1, At, B1); PG8_BAR;
            }
        }
        if constexpr (ALIGN_EPI) { if (wr == 0) PG8_BAR; }
        if constexpr (!Epi::AFTER_DRAIN) { E(acc, cur, wr, wc, fr, fq); S.done(cur); }
        if (!has_next) break;
        bool keep_acc = false; if constexpr (epi_has_carry<Epi>::value) keep_acc = E.keep(cur);
        if (!keep_acc) {
#pragma unroll
        for (int a = 0; a < 2; ++a)
#pragma unroll
            for (int b = 0; b < 2; ++b)
#pragma unroll
                for (int m = 0; m < 4; ++m)
#pragma unroll
                    for (int n = 0; n < 2; ++n) acc[a][b][m][n] = (f32x4){0.f, 0.f, 0.f, 0.f};
        }
        cur = nxt; cA = nA; cB = nB; ++ui;
        if constexpr (ALIGN_EPI) { if (wr == 1) PG8_BAR; }
    }
    PG8_WAIT_V(0);
    if constexpr (!ALIGN_EPI) { if (wr == 0) PG8_BAR; }
    PG8_BAR;
    if constexpr (Epi::AFTER_DRAIN) { E.fused(acc, cur, wr, wc, fr, fq, lds, wid, lane); S.done(cur); }
#undef PG8_SA
#undef PG8_SB
#undef PG8_STAGE
#undef PG8_LDA
#undef PG8_LDB
#undef PG8_MMA
#undef PG8_WAIT_V
#undef PG8_WAIT_L
#undef PG8_BAR
#undef PG8_SCHED
}
}

#define LAS __attribute__((address_space(3)))
typedef unsigned short bf16_t;
typedef short bf16x8 __attribute__((ext_vector_type(8)));
typedef float f32x4 __attribute__((ext_vector_type(4)));
typedef unsigned u32x4 __attribute__((ext_vector_type(4)));
typedef unsigned u32x2 __attribute__((ext_vector_type(2)));

constexpr int MTOK = 16384, SEQ = 2048, DM = 2048, NIN = 11264, DFF = 5632, NFF = 11264;
constexpr float EPS = 1e-6f;
constexpr size_t MiB = 1u << 20;
constexpr size_t WS_RSS1 = 500 * MiB, WS_RSS2 = 504 * MiB,
                  WS_KMEAN = 3 * MiB  , WS_TMC = 384 * 1024, WS_TMS = 512 * 1024, WS_QK0 = 640 * 1024  , WS_TRC = 1 * MiB, WS_TRS = 2 * MiB;
constexpr size_t WS_WIN = 4 * MiB, WS_WUP = 48 * MiB, WS_WDN = 92 * MiB, WS_WOUT = 114 * MiB, WS_WRU = 122 * MiB, WS_WMU = 126 * MiB;
constexpr size_t WS_SEC = 130 * MiB;
constexpr size_t WS_GR = 354 * MiB, WS_GM = 418 * MiB;
constexpr size_t WS_T1 = 130 * MiB, WS_MERGED = 194 * MiB, WS_X1B = 258 * MiB;
constexpr size_t WS_UH = 322 * MiB, WS_GH = 130 * MiB;
constexpr size_t WS_GF = 322 * MiB, WS_H1 = 130 * MiB, WS_H2 = 136 * MiB;
constexpr size_t WS_XBAR = 900 * 1024;
constexpr int XB_ST_OFF = 141312;
constexpr size_t WS_END = 512 * MiB;
constexpr size_t SEC_ELEMS = (size_t)MTOK * 1024;
constexpr int LDS_BYTES = 147456;
constexpr float QSCALE = 0.08838834764831845f * 1.4426950408889634f;

__device__ __forceinline__ float bflo(unsigned w) { return __uint_as_float(w << 16); }
__device__ __forceinline__ float bfhi(unsigned w) { return __uint_as_float(w & 0xffff0000u); }
__device__ __forceinline__ float ex2(float v) { return __builtin_amdgcn_exp2f(v); }
__device__ __forceinline__ float sigm(float v) { return __builtin_amdgcn_rcpf(1.f + ex2(-1.4426950408889634f * v)); }
typedef float f32x2_t __attribute__((ext_vector_type(2))); typedef __bf16 bf16x2_t __attribute__((ext_vector_type(2)));
__device__ __forceinline__ unsigned pkbf(float lo, float hi) {
#ifdef PROBE_JITTER
    lo *= PROBE_JITTER_A; hi *= PROBE_JITTER_B;
#endif
    f32x2_t v = {lo, hi}; bf16x2_t b = __builtin_convertvector(v, bf16x2_t); return __builtin_bit_cast(unsigned, b); }
__device__ __forceinline__ void st4(bf16_t* p, f32x4 v) { u32x2 w; w.x = pkbf(v[0], v[1]); w.y = pkbf(v[2], v[3]); *(u32x2*)p = w; }

namespace pg8 {
struct EpiProj {
    static constexpr bool PERM = true, AFTER_DRAIN = false;
    bf16_t* sec; bf16_t* gr; bf16_t* gm; const float* rc; const float* rs; const float* mc; const float* ms; float* kpart;
    static __device__ __forceinline__ void st8(bf16_t* p, const f32x4& a, const f32x4& b) { u32x4 w; w.x = pkbf(a[0], a[1]); w.y = pkbf(a[2], a[3]); w.z = pkbf(b[0], b[1]); w.w = pkbf(b[2], b[3]); *(u32x4*)p = w; }
    __device__ __forceinline__ void operator()(const f32x4 (&acc)[2][2][4][2], const Unit& u, int wr, int wc, int fr, int fq) const {
        const int pn = u.pn, row0 = u.pm * BM + wr * 64 + fr;
        if (pn < 28) {
            const int s = pn >> 2;
            bf16_t* base = sec + (size_t)s * SEC_ELEMS + (pn & 3) * 256 + wc * 32 + fq * 8;
            if (s <= 1) {
                const float sc = s == 1 ? 0.0625f : 1.f;
#pragma unroll
                for (int ai = 0; ai < 2; ++ai)
#pragma unroll
                    for (int m = 0; m < 4; ++m) { const int row = row0 + ai * HALF + m * 16, pos = row & (SEQ - 1); bf16_t* rowp = base + (size_t)row * 1024;
                        const int ti = pos * 128 + wc * 32 + fq * 8;
                        const f32x4 c0 = *(const f32x4*)(rc + ti), c1 = *(const f32x4*)(rc + ti + 4), s0 = *(const f32x4*)(rs + ti), s1 = *(const f32x4*)(rs + ti + 4);
                        const f32x4 a0 = acc[ai][0][m][0], a1 = acc[ai][0][m][1], b0 = acc[ai][1][m][0], b1 = acc[ai][1][m][1];
                        st8(rowp, (a0 * c0 - b0 * s0) * sc, (a1 * c1 - b1 * s1) * sc); st8(rowp + HALF, (b0 * c0 + a0 * s0) * sc, (b1 * c1 + a1 * s1) * sc); asm volatile("" ::: "memory"); }
            } else if (s == 4 || s == 5) {
                const float sc = s == 4 ? QSCALE : 1.f;
#pragma unroll
                for (int bj = 0; bj < 2; ++bj) { f32x4 cs0 = {0.f, 0.f, 0.f, 0.f}, cs1 = cs0;
                    int row0b = row0; asm volatile("" : "+v"(row0b));
#pragma unroll
                    for (int ai = 0; ai < 2; ++ai)
#pragma unroll
                        for (int m = 0; m < 4; ++m) { const int row = row0b + ai * HALF + m * 16, pos = row & (SEQ - 1); bf16_t* rowp = base + (size_t)row * 1024;
                            f32x4 o0 = acc[ai][bj][m][0], o1 = acc[ai][bj][m][1];
                            if (wc == 0) { const int ti = pos * 16 + (fq & 1) * 8; const f32x4 c0 = *(const f32x4*)(mc + ti), c1 = *(const f32x4*)(mc + ti + 4);
                                f32x4 s0 = *(const f32x4*)(ms + ti), s1 = *(const f32x4*)(ms + ti + 4); if (fq < 2) { s0 = -s0; s1 = -s1; }
                                f32x4 p0, p1;
#pragma unroll
                                for (int jj = 0; jj < 4; ++jj) { p0[jj] = __shfl_xor(o0[jj], 32); p1[jj] = __shfl_xor(o1[jj], 32); }
                                o0 = o0 * c0 + p0 * s0; o1 = o1 * c1 + p1 * s1; }
                            o0 *= sc; o1 *= sc; st8(rowp + bj * HALF, o0, o1); if (s == 5) { cs0 += o0; cs1 += o1; } asm volatile("" ::: "memory"); }
                    if (s == 5) {
#pragma unroll
                        for (int jj = 0; jj < 4; ++jj) { float v = cs0[jj]; v += __shfl_xor(v, 1); v += __shfl_xor(v, 2); v += __shfl_xor(v, 4); v += __shfl_xor(v, 8); cs0[jj] = v;
                            float w2 = cs1[jj]; w2 += __shfl_xor(w2, 1); w2 += __shfl_xor(w2, 2); w2 += __shfl_xor(w2, 4); w2 += __shfl_xor(w2, 8); cs1[jj] = w2; }
                        if (fr == 0) { float* kp = kpart + (size_t)(u.pm * 2 + wr) * 1024 + (pn & 3) * 256 + bj * HALF + wc * 32 + fq * 8; *(f32x4*)kp = cs0; *(f32x4*)(kp + 4) = cs1; } }
                    asm volatile("" ::: "memory"); }
            } else {
#pragma unroll
                for (int ai = 0; ai < 2; ++ai)
#pragma unroll
                    for (int m = 0; m < 4; ++m) { const int row = row0 + ai * HALF + m * 16; bf16_t* rowp = base + (size_t)row * 1024;
#pragma unroll
                        for (int bj = 0; bj < 2; ++bj) { f32x4 v0 = acc[ai][bj][m][0], v1 = acc[ai][bj][m][1];
                            if (s == 3) {
#pragma unroll
                                for (int jj = 0; jj < 4; ++jj) { v0[jj] *= sigm(v0[jj]); v1[jj] *= sigm(v1[jj]); } }
                            st8(rowp + bj * HALF, v0, v1); } }
            }
        } else {
            bf16_t* base = (pn < 36 ? gr : gm) + ((pn - 28) & 7) * 256 + wc * 32 + fq * 8;
#pragma unroll
            for (int ai = 0; ai < 2; ++ai)
#pragma unroll
                for (int m = 0; m < 4; ++m) { const int row = row0 + ai * HALF + m * 16; bf16_t* rowp = base + (size_t)row * DM;
#pragma unroll
                    for (int bj = 0; bj < 2; ++bj) { f32x4 v0 = acc[ai][bj][m][0], v1 = acc[ai][bj][m][1];
#pragma unroll
                        for (int jj = 0; jj < 4; ++jj) { v0[jj] = sigm(v0[jj]); v1[jj] = sigm(v1[jj]); }
                        st8(rowp + bj * HALF, v0, v1); } }
        }
    }
};
struct PairOrder {
    StaticOrder base;
    __device__ void init(int M, int N, int G_, int c_) { base.init(M, N, G_, c_); }
    __device__ bool next(int i, Unit& u) const { Unit t; if (!base.next(i >> 1, t)) return false; if (i & 1) { u.pm = t.pm; u.pn = t.pn + 8; } else { u.pm = t.pm + 64; u.pn = t.pn; } return true; }
    __device__ __forceinline__ void a_ready(const Unit&) const {}
    __device__ __forceinline__ void done(const Unit&) const {}
};
struct EpiGate2 {
    static constexpr bool PERM = true, AFTER_DRAIN = false, CARRY = true;
    const bf16_t* gr; const bf16_t* gm; bf16_t* O;
    __device__ __forceinline__ bool keep(const Unit& u) const { return u.pn < 8; }
    __device__ __forceinline__ void operator()(const f32x4 (&acc)[2][2][4][2], const Unit& u, int wr, int wc, int fr, int fq) const {
        const bool ret = u.pn < 8; const int row0 = (u.pm & 63) * BM + wr * 64 + fr, col0 = (u.pn & 7) * BM + wc * 32 + 8 * fq;
        f32x4 (&A)[2][2][4][2] = const_cast<f32x4 (&)[2][2][4][2]>(acc);
#pragma unroll
        for (int ai = 0; ai < 2; ++ai)
#pragma unroll
            for (int m = 0; m < 4; ++m) { const size_t ro = (size_t)(row0 + ai * HALF + m * 16) * DM + col0;
#pragma unroll
                for (int bj = 0; bj < 2; ++bj) { const size_t off = ro + bj * HALF; const u32x4 g2 = *(const u32x4*)(gm + off);
                    if (ret) { const u32x4 g1 = *(const u32x4*)(gr + off);
                        A[ai][bj][m][0][0] *= bflo(g1.x) * __builtin_amdgcn_rcpf(bflo(g2.x)); A[ai][bj][m][0][1] *= bfhi(g1.x) * __builtin_amdgcn_rcpf(bfhi(g2.x));
                        A[ai][bj][m][0][2] *= bflo(g1.y) * __builtin_amdgcn_rcpf(bflo(g2.y)); A[ai][bj][m][0][3] *= bfhi(g1.y) * __builtin_amdgcn_rcpf(bfhi(g2.y));
                        A[ai][bj][m][1][0] *= bflo(g1.z) * __builtin_amdgcn_rcpf(bflo(g2.z)); A[ai][bj][m][1][1] *= bfhi(g1.z) * __builtin_amdgcn_rcpf(bfhi(g2.z));
                        A[ai][bj][m][1][2] *= bflo(g1.w) * __builtin_amdgcn_rcpf(bflo(g2.w)); A[ai][bj][m][1][3] *= bfhi(g1.w) * __builtin_amdgcn_rcpf(bfhi(g2.w));
                    } else { const f32x4 v0 = acc[ai][bj][m][0], v1 = acc[ai][bj][m][1];
                        u32x4 w; w.x = pkbf(v0[0] * bflo(g2.x), v0[1] * bfhi(g2.x)); w.y = pkbf(v0[2] * bflo(g2.y), v0[3] * bfhi(g2.y));
                        w.z = pkbf(v1[0] * bflo(g2.z), v1[1] * bfhi(g2.z)); w.w = pkbf(v1[2] * bflo(g2.w), v1[3] * bfhi(g2.w));
                        *(u32x4*)(O + off) = w; } }
                if (m == 3) asm volatile("" ::: "memory"); }
    }
};
struct EpiGate {
    static constexpr bool PERM = true, AFTER_DRAIN = false;
    const bf16_t* gate; const bf16_t* addsrc; bf16_t* O;
    __device__ __forceinline__ void operator()(const f32x4 (&acc)[2][2][4][2], const Unit& u, int wr, int wc, int fr, int fq) const {
        const int row0 = u.pm * BM + wr * 64 + fr, col0 = u.pn * BM + wc * 32 + 8 * fq;
#pragma unroll
        for (int ai = 0; ai < 2; ++ai)
#pragma unroll
            for (int m = 0; m < 4; ++m) { const size_t ro = (size_t)(row0 + ai * HALF + m * 16) * DM + col0;
#pragma unroll
                for (int bj = 0; bj < 2; ++bj) { const size_t off = ro + bj * HALF; const u32x4 g = *(const u32x4*)(gate + off);
                    const f32x4 v0 = acc[ai][bj][m][0], v1 = acc[ai][bj][m][1];
                    float r0 = v0[0] * bflo(g.x), r1 = v0[1] * bfhi(g.x), r2 = v0[2] * bflo(g.y), r3 = v0[3] * bfhi(g.y);
                    float r4 = v1[0] * bflo(g.z), r5 = v1[1] * bfhi(g.z), r6 = v1[2] * bflo(g.w), r7 = v1[3] * bfhi(g.w);
                    if (addsrc) { const u32x4 t = *(const u32x4*)(addsrc + off);
                        r0 += bflo(t.x); r1 += bfhi(t.x); r2 += bflo(t.y); r3 += bfhi(t.y); r4 += bflo(t.z); r5 += bfhi(t.z); r6 += bflo(t.w); r7 += bfhi(t.w); }
                    u32x4 w; w.x = pkbf(r0, r1); w.y = pkbf(r2, r3); w.z = pkbf(r4, r5); w.w = pkbf(r6, r7);
                    *(u32x4*)(O + off) = w; } }
    }
};
struct EpiRes {
    static constexpr bool PERM = true, AFTER_DRAIN = false;
    const float* xi; float* xo; bf16_t* xb; float* rowss;
    __device__ __forceinline__ void operator()(const f32x4 (&acc)[2][2][4][2], const Unit& u, int wr, int wc, int fr, int fq) const {
        const int row0 = u.pm * BM + wr * 64 + fr, col0 = u.pn * BM + wc * 32 + 8 * fq;
#pragma unroll
        for (int ai = 0; ai < 2; ++ai)
#pragma unroll
            for (int m = 0; m < 4; ++m) { const int row = row0 + ai * HALF + m * 16; const size_t ro = (size_t)row * DM + col0; float ss = 0.f;
#pragma unroll
                for (int bj = 0; bj < 2; ++bj) { const size_t off = ro + bj * HALF;
                    f32x4 a0 = *(const f32x4*)(xi + off), a1 = *(const f32x4*)(xi + off + 4);
                    a0 += acc[ai][bj][m][0]; a1 += acc[ai][bj][m][1];
                    *(f32x4*)(xo + off) = a0; *(f32x4*)(xo + off + 4) = a1;
                    if (xb) { u32x4 w; w.x = pkbf(a0[0], a0[1]); w.y = pkbf(a0[2], a0[3]); w.z = pkbf(a1[0], a1[1]); w.w = pkbf(a1[2], a1[3]); *(u32x4*)(xb + off) = w; }
                    ss += (a0[0] * a0[0] + a0[1] * a0[1]) + (a0[2] * a0[2] + a0[3] * a0[3]) + (a1[0] * a1[0] + a1[1] * a1[1]) + (a1[2] * a1[2] + a1[3] * a1[3]); }
                ss += __shfl_xor(ss, 16); ss += __shfl_xor(ss, 32);
                if (fq == 0) rowss[(size_t)row * 32 + u.pn * 4 + wc] = ss; }
    }
};
#ifndef PLAIN_PERM
#define PLAIN_PERM true
#endif
struct EpiPlain {
    static constexpr bool PERM = PLAIN_PERM, AFTER_DRAIN = false;
    bf16_t* U; int ld;
    __device__ __forceinline__ void operator()(const f32x4 (&acc)[2][2][4][2], const Unit& u, int wr, int wc, int fr, int fq) const {
        const int row0 = u.pm * BM + wr * 64 + fr, col0 = u.pn * BM + wc * 32 + 8 * fq;
#pragma unroll
        for (int ai = 0; ai < 2; ++ai)
#pragma unroll
            for (int m = 0; m < 4; ++m) { const int row = row0 + ai * HALF + m * 16; bf16_t* rowp = U + (size_t)row * ld + col0;
#pragma unroll
                for (int bj = 0; bj < 2; ++bj) { const f32x4 v0 = acc[ai][bj][m][0], v1 = acc[ai][bj][m][1];
                    u32x4 w; w.x = pkbf(v0[0], v0[1]); w.y = pkbf(v0[2], v0[3]); w.z = pkbf(v1[0], v1[1]); w.w = pkbf(v1[2], v1[3]);
                    *(u32x4*)(rowp + bj * HALF) = w; } }
    }
};
struct EpiUp {
    static constexpr bool PERM = true, AFTER_DRAIN = false;
    bf16_t* U; const float* rowss;
    __device__ __forceinline__ void operator()(const f32x4 (&acc)[2][2][4][2], const Unit& u, int wr, int wc, int fr, int fq) const {
        const int row0 = u.pm * BM + wr * 64 + fr, col0 = u.pn * BM + wc * 32 + 8 * fq;
#pragma unroll
        for (int ai = 0; ai < 2; ++ai)
#pragma unroll
            for (int m = 0; m < 4; ++m) { const int row = row0 + ai * HALF + m * 16; const float* pp = rowss + (size_t)row * 32 + 8 * fq; const f32x4 p0 = *(const f32x4*)pp, p1 = *(const f32x4*)(pp + 4);
                float sq = ((p0[0] + p0[1]) + (p0[2] + p0[3])) + ((p1[0] + p1[1]) + (p1[2] + p1[3])); sq += __shfl_xor(sq, 16); sq += __shfl_xor(sq, 32);
                const float r = __builtin_amdgcn_rsqf(sq * (1.f / DM) + EPS);
                bf16_t* rowp = U + (size_t)row * NFF + col0;
#pragma unroll
                for (int bj = 0; bj < 2; ++bj) { const f32x4 v0 = acc[ai][bj][m][0] * r, v1 = acc[ai][bj][m][1] * r;
                    u32x4 w; w.x = pkbf(v0[0], v0[1]); w.y = pkbf(v0[2], v0[3]); w.z = pkbf(v1[0], v1[1]); w.w = pkbf(v1[2], v1[3]);
                    *(u32x4*)(rowp + bj * HALF) = w; } }
    }
};

__device__ __forceinline__ float dpp_ror1(float v) { return __builtin_bit_cast(float, __builtin_amdgcn_mov_dpp(__builtin_bit_cast(int, v), 0x121, 0xf, 0xf, true)); }
__device__ __forceinline__ float dpp_ror2(float v) { return __builtin_bit_cast(float, __builtin_amdgcn_mov_dpp(__builtin_bit_cast(int, v), 0x122, 0xf, 0xf, true)); }
struct EpiConv {
    static constexpr bool PERM = true, AFTER_DRAIN = false;
    bf16_t* G; const float* rowss; const float* cw; const float* cbias; float* H1; float* H2; PG8_LAS unsigned char* xl;
    __device__ __forceinline__ void operator()(const f32x4 (&acc)[2][2][4][2], const Unit& u, int wr, int wc, int fr_, int fq_) const {
        int ln_ = threadIdx.x & 63; asm volatile("" : "+v"(ln_)); const int fr = ln_ & 15, fq = ln_ >> 4; (void)fr_; (void)fq_;

        const int row0 = u.pm * BM + wr * 64 + fr, ch0 = u.pn * 128 + wc * 32 + 8 * fq, tc0 = u.pn * 256 + wc * 32 + 8 * fq;
        f32x4 (&A)[2][2][4][2] = const_cast<f32x4 (&)[2][2][4][2]>(acc);
        PG8_LAS float* rs = (PG8_LAS float*)(xl + 8192);
        { const int t = threadIdx.x; if (t < 256) { const f32x4* pp = (const f32x4*)(rowss + (size_t)(u.pm * BM + t) * 32); float sq = 0.f;
#pragma unroll
              for (int q = 0; q < 8; ++q) { const f32x4 p = pp[q]; sq += (p[0] + p[1]) + (p[2] + p[3]); }
              rs[t] = __builtin_amdgcn_rsqf(sq * (1.f / DM) + EPS); } }
        asm volatile("s_waitcnt lgkmcnt(0)" ::: "memory"); __builtin_amdgcn_s_barrier(); asm volatile("" ::: "memory");
#pragma unroll
        for (int ai = 0; ai < 2; ++ai)
#pragma unroll
            for (int m = 0; m < 4; ++m) { const float rr = rs[ai * HALF + wr * 64 + m * 16 + fr];
                A[ai][0][m][0] *= rr; A[ai][0][m][1] *= rr; A[ai][1][m][0] *= rr; A[ai][1][m][1] *= rr; }
        PG8_LAS f32x4* X = (PG8_LAS f32x4*)xl;
        if (fr >= 14) {
#pragma unroll
            for (int ai = 0; ai < 2; ++ai)
#pragma unroll
                for (int bj = 0; bj < 2; ++bj)
#pragma unroll
                    for (int n = 0; n < 2; ++n) X[(((((ai * 2 + wr) * 4 + wc) * 2 + (fr - 14)) * 4 + fq) * 4) + bj * 2 + n] = A[ai][bj][3][n];
            if (wr == 1) {
#pragma unroll
                for (int bj = 0; bj < 2; ++bj)
#pragma unroll
                    for (int n = 0; n < 2; ++n) *(f32x4*)(H1 + (size_t)(u.pm * 2 + (fr - 14)) * NFF + tc0 + bj * HALF + 4 * n) = A[1][bj][3][n]; }
        }
        if (wr == 0 && fr < 2) {
#pragma unroll
            for (int bj = 0; bj < 2; ++bj)
#pragma unroll
                for (int n = 0; n < 2; ++n) *(f32x4*)(H2 + (size_t)(u.pm * 2 + fr) * NFF + tc0 + bj * HALF + 4 * n) = A[0][bj][0][n]; }
        asm volatile("s_waitcnt lgkmcnt(0)" ::: "memory"); __builtin_amdgcn_s_barrier(); asm volatile("" ::: "memory");
#pragma unroll
        for (int n = 0; n < 2; ++n)
#pragma unroll
            for (int ai = 0; ai < 2; ++ai) {
                const bool hasprev = (wr == 1 || ai == 1); const int sai = wr == 1 ? ai : 0, swr = wr == 1 ? 0 : 1, base = ((sai * 2 + swr) * 4 + wc) * 2;
                const int i1 = ((base + 1) * 4 + fq) * 4 + n, i2 = ((base + (fr & 1)) * 4 + fq) * 4 + n;
                f32x4 sa[4];
                { const float* cwp = cw + ch0 + 4 * n; const f32x4 w0 = *(const f32x4*)cwp, w1 = *(const f32x4*)(cwp + NFF), w2 = *(const f32x4*)(cwp + 2 * NFF), bv = *(const f32x4*)(cbias + ch0 + 4 * n);
                  f32x4 P1 = {0.f, 0.f, 0.f, 0.f}, P2 = P1; if (hasprev) { P1 = X[i1]; P2 = X[i2]; }
#pragma unroll
                  for (int m = 0; m < 4; ++m) { const f32x4 c = A[ai][0][m][n]; f32x4 R1, R2;
#pragma unroll
                      for (int jj = 0; jj < 4; ++jj) { R1[jj] = dpp_ror1(c[jj]); R2[jj] = dpp_ror2(c[jj]); }
                      const f32x4 p1 = fr >= 1 ? R1 : P1, p2 = fr >= 2 ? R2 : P2; const f32x4 y = bv + w0 * p2 + w1 * p1 + w2 * c;
                      sa[m][0] = y[0] * sigm(y[0]); sa[m][1] = y[1] * sigm(y[1]); sa[m][2] = y[2] * sigm(y[2]); sa[m][3] = y[3] * sigm(y[3]); P1 = R1; P2 = R2; } }
                asm volatile("" ::: "memory");
                { const float* cwp = cw + DFF + ch0 + 4 * n; const f32x4 w0 = *(const f32x4*)cwp, w1 = *(const f32x4*)(cwp + NFF), w2 = *(const f32x4*)(cwp + 2 * NFF), bv = *(const f32x4*)(cbias + DFF + ch0 + 4 * n);
                  f32x4 P1 = {0.f, 0.f, 0.f, 0.f}, P2 = P1; if (hasprev) { P1 = X[i1 + 2]; P2 = X[i2 + 2]; }
#pragma unroll
                  for (int m = 0; m < 4; ++m) { const f32x4 c = A[ai][1][m][n]; f32x4 R1, R2;
#pragma unroll
                      for (int jj = 0; jj < 4; ++jj) { R1[jj] = dpp_ror1(c[jj]); R2[jj] = dpp_ror2(c[jj]); }
                      const f32x4 p1 = fr >= 1 ? R1 : P1, p2 = fr >= 2 ? R2 : P2; const f32x4 y = bv + w0 * p2 + w1 * p1 + w2 * c;
                      st4(G + (size_t)(row0 + ai * HALF + m * 16) * DFF + ch0 + 4 * n, sa[m] * y); P1 = R1; P2 = R2; } }
                asm volatile("" ::: "memory");
            }
    }
};
}

__device__ __forceinline__ float wave_sum(float v) {
#pragma unroll
    for (int o = 1; o < 64; o <<= 1) v += __shfl_xor(v, o);
    return v;
}
template <int DK, int DV, bool SOFTMAX>
__device__ __forceinline__ void attn_unit(LAS unsigned char* lds, const bf16_t* Qg, const bf16_t* Kg, const bf16_t* Vg, bf16_t* Og, int b, int h, int qt,
                                          const float* normw, const bf16_t* rgate, float log2g, const float* kmean, const float* qk0, const float* trc, const float* trs) {
    constexpr int KST = (DK + 8) * 2, VST = 144, KS_OFF = 0, VT_OFF = 64 * KST, LIST_OFF = VT_OFF + DV * VST, NS = DK / 32, NT = DV / 16;
    constexpr int NKC = (64 * DK / 8) / 512, NVC = (32 * DV / 8) / 512;
    const int tid = threadIdx.x, w = __builtin_amdgcn_readfirstlane(tid >> 6), lane = tid & 63, c = lane & 15, kq = lane >> 4;
    const int t0 = qt * 128, cb = t0 >> 8, qi = t0 + 16 * w + c;
    const size_t rowbase = (size_t)b * SEQ;
    LAS int* list = (LAS int*)(lds + LIST_OFF);
    bf16x8 bq[NS];
    { const bf16_t* qp = Qg + (rowbase + qi) * 1024 + h * DK + 8 * kq;
#pragma unroll
      for (int s = 0; s < NS; ++s) bq[s] = *(const bf16x8*)(qp + 32 * s); }
    unsigned selmask = 0u;
    __syncthreads();
    if constexpr (SOFTMAX) {
        float bs[7];
#pragma unroll
        for (int n = 0; n < 7; ++n) { bs[n] = -INFINITY;
            if (n < cb) { const float* km = kmean + (size_t)((b * 8 + n) * 2) * 1024 + h * 128 + 8 * kq; float a = 0.f;
#pragma unroll
                for (int s = 0; s < NS; ++s) { const f32x4 k0v = *(const f32x4*)(km + 32 * s) + *(const f32x4*)(km + 1024 + 32 * s), k1v = *(const f32x4*)(km + 32 * s + 4) + *(const f32x4*)(km + 1024 + 32 * s + 4);
                    a += __uint_as_float((unsigned)(unsigned short)bq[s][0] << 16) * k0v[0] + __uint_as_float((unsigned)(unsigned short)bq[s][1] << 16) * k0v[1]
                       + __uint_as_float((unsigned)(unsigned short)bq[s][2] << 16) * k0v[2] + __uint_as_float((unsigned)(unsigned short)bq[s][3] << 16) * k0v[3]
                       + __uint_as_float((unsigned)(unsigned short)bq[s][4] << 16) * k1v[0] + __uint_as_float((unsigned)(unsigned short)bq[s][5] << 16) * k1v[1]
                       + __uint_as_float((unsigned)(unsigned short)bq[s][6] << 16) * k1v[2] + __uint_as_float((unsigned)(unsigned short)bq[s][7] << 16) * k1v[3]; }
                a += __shfl_xor(a, 16); a += __shfl_xor(a, 32); bs[n] = a;
#ifdef PROBE_NOISE
                bs[n] += 0.002f * (float)(((unsigned)(qi * 7 + n * 13 + h * 5 + b * 3) * 2654435761u >> 24) & 255u) * (1.f / 256.f);
#endif
            } }
        if (cb <= 3) selmask = (1u << cb) - 1u;
        else {
#pragma unroll
            for (int pick = 0; pick < 3; ++pick) { float best = -INFINITY; int bi = 0;
#pragma unroll
                for (int n = 0; n < 7; ++n) if (n < cb && !((selmask >> n) & 1u) && bs[n] > best) { best = bs[n]; bi = n; }
                selmask |= 1u << bi; } }
        unsigned um = selmask; um |= __shfl_xor(um, 1); um |= __shfl_xor(um, 2); um |= __shfl_xor(um, 4); um |= __shfl_xor(um, 8);
        if (lane == 0) list[48 + w] = (int)um;
        __syncthreads();
    }
    if (tid == 0) { int n = 0;
        if constexpr (SOFTMAX) { unsigned um = 0u; for (int i = 0; i < 8; ++i) um |= (unsigned)list[48 + i];
            for (int k = cb * 256; k < t0 + 128; k += 64) list[1 + n++] = k;
            for (int nb = 0; nb < cb; ++nb) if ((um >> nb) & 1u) for (int k = 0; k < 256; k += 64) list[1 + n++] = nb * 256 + k; }
        else { for (int k = 0; k < t0 + 128; k += 64) list[1 + n++] = k; }
        list[0] = n; }
    __syncthreads();
    const int cnt = list[0];

    f32x4 O[NT];
#pragma unroll
    for (int t = 0; t < NT; ++t) O[t] = (f32x4){0.f, 0.f, 0.f, 0.f};
    float m_run = -1e30f, l_run = 0.f;
    u32x4 kreg[NKC], v0r[NVC], v1r[NVC];
    const bf16_t* Kh = Kg + rowbase * 1024 + h * DK; const bf16_t* Vh = Vg + rowbase * 1024 + h * DV;
#define ATT_LOAD(k0_) do { const int k0__ = (k0_); _Pragma("unroll") for (int i = 0; i < NKC; ++i) { const int q = tid + 512 * i, row = q / (DK / 8), cc = q % (DK / 8); \
            kreg[i] = *(const u32x4*)(Kh + (size_t)(k0__ + row) * 1024 + 8 * cc); } \
        _Pragma("unroll") for (int i = 0; i < NVC; ++i) { const int q = tid + 512 * i, jp = q & 31, cc = q >> 5; \
            v0r[i] = *(const u32x4*)(Vh + (size_t)(k0__ + 2 * jp) * 1024 + 8 * cc); v1r[i] = *(const u32x4*)(Vh + (size_t)(k0__ + 2 * jp + 1) * 1024 + 8 * cc); } } while (0)
    ATT_LOAD(list[1]);
    const int kbase = KS_OFF + (8 * (c >> 2) + (c & 3)) * KST + 16 * kq, vbase = VT_OFF + c * VST + 16 * kq;
    for (int it = 0; it < cnt; ++it) {
        const int k0 = list[1 + it];
        __syncthreads();
#pragma unroll
        for (int i = 0; i < NKC; ++i) { const int q = tid + 512 * i, row = q / (DK / 8), cc = q % (DK / 8); *(LAS u32x4*)(lds + KS_OFF + row * KST + cc * 16) = kreg[i]; }
#pragma unroll
        for (int i = 0; i < NVC; ++i) { const int q = tid + 512 * i, jp = q & 31, cc = q >> 5;
#pragma unroll
            for (int e2 = 0; e2 < 4; ++e2) { const unsigned a = v0r[i][e2], bb = v1r[i][e2];
                *(LAS unsigned*)(lds + VT_OFF + (8 * cc + 2 * e2) * VST + jp * 4) = (a & 0xffffu) | (bb << 16);
                *(LAS unsigned*)(lds + VT_OFF + (8 * cc + 2 * e2 + 1) * VST + jp * 4) = (a >> 16) | (bb & 0xffff0000u); } }
        __syncthreads();
        if (it + 1 < cnt) ATT_LOAD(list[2 + it]);
        f32x4 S[4];
#pragma unroll
        for (int T = 0; T < 4; ++T) S[T] = (f32x4){0.f, 0.f, 0.f, 0.f};
#pragma unroll
        for (int s = 0; s < NS; ++s)
#pragma unroll
            for (int T = 0; T < 4; ++T) { const bf16x8 a = *(const LAS bf16x8*)(lds + kbase + (32 * (T >> 1) + 4 * (T & 1)) * KST + 64 * s);
                S[T] = __builtin_amdgcn_mfma_f32_16x16x32_bf16(a, bq[s], S[T], 0, 0, 0); }
        if constexpr (SOFTMAX) {
            const int nb = k0 >> 8; const bool own = nb == cb, rowsel = (selmask >> nb) & 1u; float tmax = -1e30f;
#pragma unroll
            for (int T = 0; T < 4; ++T)
#pragma unroll
                for (int jj = 0; jj < 4; ++jj) { const int j = k0 + 32 * (T >> 1) + 8 * kq + 4 * (T & 1) + jj; const bool ok = own ? (j <= qi) : rowsel;
                    S[T][jj] = ok ? S[T][jj] : -1e30f; tmax = fmaxf(tmax, S[T][jj]); }
            tmax = fmaxf(tmax, __shfl_xor(tmax, 16)); tmax = fmaxf(tmax, __shfl_xor(tmax, 32));
            const float m_new = fmaxf(m_run, tmax), alpha = ex2(m_run - m_new); m_run = m_new; float ps = 0.f;
#pragma unroll
            for (int T = 0; T < 4; ++T)
#pragma unroll
                for (int jj = 0; jj < 4; ++jj) { S[T][jj] = ex2(S[T][jj] - m_new); ps += S[T][jj]; }
            l_run = l_run * alpha + ps;
#pragma unroll
            for (int t = 0; t < NT; ++t) O[t] *= alpha;
        } else {
#pragma unroll
            for (int T = 0; T < 4; ++T)
#pragma unroll
                for (int jj = 0; jj < 4; ++jj) { const int d = qi - (k0 + 32 * (T >> 1) + 8 * kq + 4 * (T & 1) + jj);
                    S[T][jj] = d >= 0 ? S[T][jj] * ex2(log2g * (float)d) : 0.f; }
        }
        bf16x8 pb[2];
#pragma unroll
        for (int sp = 0; sp < 2; ++sp) { u32x4 pw; pw.x = pkbf(S[2 * sp][0], S[2 * sp][1]); pw.y = pkbf(S[2 * sp][2], S[2 * sp][3]);
            pw.z = pkbf(S[2 * sp + 1][0], S[2 * sp + 1][1]); pw.w = pkbf(S[2 * sp + 1][2], S[2 * sp + 1][3]); pb[sp] = __builtin_bit_cast(bf16x8, pw); }
#pragma unroll
        for (int t = 0; t < NT; ++t)
#pragma unroll
            for (int sp = 0; sp < 2; ++sp) { const bf16x8 a = *(const LAS bf16x8*)(lds + vbase + 16 * t * VST + 64 * sp);
                O[t] = __builtin_amdgcn_mfma_f32_16x16x32_bf16(a, pb[sp], O[t], 0, 0, 0); }
    }
#undef ATT_LOAD
    const size_t orow = (rowbase + qi) * 1024 + h * DV + 4 * kq;
    if constexpr (SOFTMAX) {
        float l = l_run; l += __shfl_xor(l, 16); l += __shfl_xor(l, 32); const float inv = 1.f / l;
#pragma unroll
        for (int t = 0; t < NT; ++t) st4(Og + orow + 16 * t, O[t] * inv);
    } else {
        if (qt == 0 && w == 0) {
            float qa[4][4], ka[4][4];
#pragma unroll
            for (int tk = 0; tk < 4; ++tk) { const float* q0 = qk0 + ((size_t)tk * 8 + b) * 2048 + h * 256 + 2 * lane;
                const float c0 = trc[tk * 128 + 2 * lane], c1 = trc[tk * 128 + 2 * lane + 1], s0 = trs[tk * 128 + 2 * lane], s1 = trs[tk * 128 + 2 * lane + 1];
                const float q1a = q0[0], q1b = q0[1], q2a = q0[128], q2b = q0[129], k1a = q0[1024], k1b = q0[1025], k2a = q0[1152], k2b = q0[1153];
                qa[tk][0] = q1a * c0 - q2a * s0; qa[tk][1] = q1b * c1 - q2b * s1; qa[tk][2] = q2a * c0 + q1a * s0; qa[tk][3] = q2b * c1 + q1b * s1;
                ka[tk][0] = k1a * c0 - k2a * s0; ka[tk][1] = k1b * c1 - k2b * s1; ka[tk][2] = k2a * c0 + k1a * s0; ka[tk][3] = k2b * c1 + k1b * s1; }
            float cf[4] = {0.f, 0.f, 0.f, 0.f};
#pragma unroll
            for (int tk = 0; tk < 4; ++tk)
#pragma unroll
                for (int j = 0; j <= tk; ++j) { const float sc = wave_sum((qa[tk][0] * ka[j][0] + qa[tk][1] * ka[j][1]) + (qa[tk][2] * ka[j][2] + qa[tk][3] * ka[j][3])) * 0.0625f * ex2(log2g * (float)(tk - j));
                    if (c == tk) cf[j] = sc; }
            if (c < 4) {
#pragma unroll
                for (int t = 0; t < NT; ++t) { f32x4 o = {0.f, 0.f, 0.f, 0.f};
#pragma unroll
                    for (int j = 0; j < 4; ++j) { const u32x2 v = *(const u32x2*)(Vg + (rowbase + j) * 1024 + h * DV + 4 * kq + 16 * t);
                        o[0] += cf[j] * bflo(v.x); o[1] += cf[j] * bfhi(v.x); o[2] += cf[j] * bflo(v.y); o[3] += cf[j] * bfhi(v.y); }
                    O[t] = o; } } }
        float ss = 0.f;
#pragma unroll
        for (int t = 0; t < NT; ++t) ss += (O[t][0] * O[t][0] + O[t][1] * O[t][1]) + (O[t][2] * O[t][2] + O[t][3] * O[t][3]);
        ss += __shfl_xor(ss, 16); ss += __shfl_xor(ss, 32);
        const float rn = 1.f / sqrtf(ss * (1.f / DV) + EPS);
#pragma unroll
        for (int t = 0; t < NT; ++t) { const f32x4 wv = *(const f32x4*)(normw + h * DV + 4 * kq + 16 * t); const u32x2 g = *(const u32x2*)(rgate + orow + 16 * t);
            f32x4 o = O[t] * rn * wv; o[0] *= bflo(g.x); o[1] *= bfhi(g.x); o[2] *= bflo(g.y); o[3] *= bfhi(g.y);
            st4(Og + orow + 16 * t, o); }
    }
}

__device__ __forceinline__ void p0_transpose_item(const float* W, int K, int N, bf16_t* WT, const float* kscale, LAS float* scr, int item, int lane, bool ffn_perm = false) {
    const int nblk = N / 32, kb = item / nblk, nb = item % nblk, k0 = 64 * kb, n0 = 32 * nb;
    const int r0 = !ffn_perm ? n0 : (n0 < DFF ? (n0 >> 7) * 256 + (n0 & 127) : ((n0 - DFF) >> 7) * 256 + 128 + ((n0 - DFF) & 127));
    { const int kr = lane >> 3, nc = lane & 7; f32x4 v[8];
#pragma unroll
      for (int i = 0; i < 8; ++i) v[i] = *(const f32x4*)(W + (size_t)(k0 + 8 * i + kr) * N + n0 + 4 * nc);
#pragma unroll
      for (int i = 0; i < 8; ++i) { const int kk = 8 * i + kr; f32x4 t = v[i]; if (kscale) t *= kscale[k0 + kk]; LAS float* d = scr + kk * 33 + 4 * nc; d[0] = t[0]; d[1] = t[1]; d[2] = t[2]; d[3] = t[3]; } }
    asm volatile("s_waitcnt lgkmcnt(0)" ::: "memory");
    const int c = lane & 7;
#pragma unroll
    for (int j = 0; j < 4; ++j) { const int n = (lane >> 3) + 8 * j; const LAS float* s = scr + (8 * c) * 33 + n;
        u32x4 o; o.x = pkbf(s[0 * 33], s[1 * 33]); o.y = pkbf(s[2 * 33], s[3 * 33]); o.z = pkbf(s[4 * 33], s[5 * 33]); o.w = pkbf(s[6 * 33], s[7 * 33]);
        *(u32x4*)(WT + (size_t)(r0 + n) * K + k0 + 8 * c) = o; }
    asm volatile("s_waitcnt lgkmcnt(0)" ::: "memory");
}

struct TrItem { const float* W; bf16_t* WT; const float* kscale; int K, N, item, perm; };
__device__ __forceinline__ void p0_tr_load(const TrItem& d, int lane, f32x4 (&v)[8]) {
    const int nblk = d.N / 32, kb = d.item / nblk, nb = d.item % nblk, k0 = 64 * kb, n0 = 32 * nb, kr = lane >> 3, nc = lane & 7;
#pragma unroll
    for (int i = 0; i < 8; ++i) v[i] = *(const f32x4*)(d.W + (size_t)(k0 + 8 * i + kr) * d.N + n0 + 4 * nc);
}
__device__ __forceinline__ void p0_tr_finish(const TrItem& d, int lane, const f32x4 (&v)[8], LAS float* scr) {
    const int nblk = d.N / 32, kb = d.item / nblk, nb = d.item % nblk, k0 = 64 * kb, n0 = 32 * nb, kr = lane >> 3, nc = lane & 7;
    const int r0 = !d.perm ? n0 : (n0 < DFF ? (n0 >> 7) * 256 + (n0 & 127) : ((n0 - DFF) >> 7) * 256 + 128 + ((n0 - DFF) & 127));
#pragma unroll
    for (int i = 0; i < 8; ++i) { const int kk = 8 * i + kr; f32x4 t = v[i]; if (d.kscale) t *= d.kscale[k0 + kk]; LAS float* q = scr + kk * 33 + 4 * nc; q[0] = t[0]; q[1] = t[1]; q[2] = t[2]; q[3] = t[3]; }
    asm volatile("s_waitcnt lgkmcnt(0)" ::: "memory");
    const int c = lane & 7;
#pragma unroll
    for (int j = 0; j < 4; ++j) { const int n = (lane >> 3) + 8 * j; const LAS float* s = scr + (8 * c) * 33 + n;
        u32x4 o; o.x = pkbf(s[0 * 33], s[1 * 33]); o.y = pkbf(s[2 * 33], s[3 * 33]); o.z = pkbf(s[4 * 33], s[5 * 33]); o.w = pkbf(s[6 * 33], s[7 * 33]);
        *(u32x4*)(d.WT + (size_t)(r0 + n) * d.K + k0 + 8 * c) = o; }
    asm volatile("s_waitcnt lgkmcnt(0)" ::: "memory");
}
#define RLX_AGENT __ATOMIC_RELAXED, __HIP_MEMORY_SCOPE_AGENT
#define XB_TMO      128
#define XB_XCNT(j)  (256  + 64 * (j))
#define XB_XSUB(j)  (1280 + 64 * (j))
#define XB_XGEN(j)  (2304 + 64 * (j))
#define XB_TOP      3328
#define XB_TOPGEN   3392
#define XCD_BAR_WORDS 3456
#define XB_SPIN_CAP (1u << 18)

__device__ __forceinline__ unsigned xb_ld(unsigned* p)              { return __hip_atomic_load(p, __ATOMIC_RELAXED, __HIP_MEMORY_SCOPE_AGENT); }
__device__ __forceinline__ unsigned xb_add(unsigned* p, unsigned v) { return __hip_atomic_fetch_add(p, v, __ATOMIC_RELAXED, __HIP_MEMORY_SCOPE_AGENT); }
__device__ __forceinline__ unsigned xb_xcc_id() { return (unsigned)__builtin_amdgcn_s_getreg((3 << 11) | 20) & 0xFu; }
#define XB_SPIN(cond, bar) do { unsigned _sp = 0; while (cond) { __builtin_amdgcn_s_sleep(1); \
    if ((++_sp & 255u) == 0u) { if (xb_ld(&(bar)[XB_TMO])) break; if (_sp > XB_SPIN_CAP) { atomicAdd(&(bar)[XB_TMO], 1u); break; } } } } while (0)

struct XcdBarrier {
    unsigned* bar; unsigned x;
    volatile LAS unsigned* st;
};

__device__ __forceinline__ XcdBarrier xcd_barrier_post(unsigned* bar, volatile LAS unsigned* st) {
    XcdBarrier b; b.bar = bar; b.x = xb_xcc_id(); b.st = st;
    if (threadIdx.x == 0) (void)xb_add(&bar[XB_XCNT(b.x)], 1u);
    return b;
}
__device__ __forceinline__ void xcd_barrier_complete(unsigned* bar, unsigned x, unsigned& nloc, unsigned& nx) {
    const unsigned G = gridDim.x * gridDim.y * gridDim.z;
    unsigned sum, cnt, mine, sp = 0u;
    for (;;) {
        sum = 0u; cnt = 0u; mine = 0u;
#pragma unroll
        for (unsigned j = 0; j < 16; ++j) { const unsigned c = xb_ld(&bar[XB_XCNT(j)]); sum += c; cnt += (c > 0u) ? 1u : 0u; mine = (j == x) ? c : mine; }
        if (sum == G) break;
        __builtin_amdgcn_s_sleep(1);
        if ((++sp & 255u) == 0u) { if (xb_ld(&bar[XB_TMO])) break; if (sp > XB_SPIN_CAP) { atomicAdd(&bar[XB_TMO], 1u); break; } }
    }
    nloc = mine > 0u ? mine : 1u; nx = cnt > 0u ? cnt : 1u;
}

__device__ __forceinline__ void xcd_barrier(const XcdBarrier& b) {
    asm volatile("s_waitcnt vmcnt(0)" ::: "memory");
    __syncthreads();
    if (threadIdx.x == 0) {
        unsigned* bar = b.bar;
        __builtin_amdgcn_s_waitcnt(0);
        unsigned nloc = b.st[0], nx = b.st[1];
        if (nloc == 0u) { xcd_barrier_complete(bar, b.x, nloc, nx); b.st[0] = nloc; b.st[1] = nx; }
        const unsigned old = xb_add(&bar[XB_XSUB(b.x)], 1u);
        const unsigned gen = old / nloc;
        if (old + 1u == (gen + 1u) * nloc) {
            __builtin_amdgcn_fence(__ATOMIC_RELEASE, "agent");
            asm volatile("s_waitcnt vmcnt(0)" ::: "memory");
            const unsigned og = xb_add(&bar[XB_TOP], 1u);
            const unsigned tg = og / nx;
            if (og + 1u == (tg + 1u) * nx) xb_add(&bar[XB_TOPGEN], 1u);
            else XB_SPIN(xb_ld(&bar[XB_TOPGEN]) == tg, bar);
            __builtin_amdgcn_fence(__ATOMIC_ACQUIRE, "agent");
            xb_add(&bar[XB_XGEN(b.x)], 1u);
            asm volatile("s_waitcnt vmcnt(0)" ::: "memory");
        } else {
            XB_SPIN(xb_ld(&bar[XB_XGEN(b.x)]) == gen, bar);
            __builtin_amdgcn_fence(__ATOMIC_ACQUIRE, "agent");
            asm volatile("s_waitcnt vmcnt(0)" ::: "memory");
        }
    }
    __syncthreads();
}

struct Args { const float* in[13]; float* out; unsigned char* ws; };

__device__ __forceinline__ const __attribute__((address_space(4))) Args* kargs() { const __attribute__((address_space(4))) Args* p = (const __attribute__((address_space(4))) Args*)__builtin_amdgcn_kernarg_segment_ptr(); asm volatile("" : "+s"(p)); return p; }
#ifndef PROBE_SYNCN
#define PROBE_SYNCN 1
#endif
#define GRID_SYNC() for (int gs_ = 0; gs_ < PROBE_SYNCN; ++gs_) do { asm volatile("s_waitcnt vmcnt(0) lgkmcnt(0)" ::: "memory"); grid.sync(); asm volatile("s_waitcnt vmcnt(0)" ::: "memory"); __builtin_amdgcn_s_barrier(); asm volatile("" ::: "memory"); } while (0)
#define XSYNC() do { XcdBarrier xb_; xb_.bar = (unsigned*)(kargs()->ws + WS_XBAR); xb_.x = xb_xcc_id(); xb_.st = (volatile LAS unsigned*)(lds + XB_ST_OFF); xcd_barrier(xb_); } while (0)
#define PV \
    const __attribute__((address_space(4))) Args* ap = kargs(); \
    int tid = threadIdx.x; asm volatile("" : "+v"(tid)); \
    const int lane = tid & 63, wave = __builtin_amdgcn_readfirstlane(tid >> 6); \
    const int G = gridDim.x, bx = blockIdx.x; \
    unsigned char* ws = ap->ws; \
    const float* x = ap->in[0]; const float* attn_norm_w = ap->in[1]; const float* w_in = ap->in[2]; const float* ret_norm_w = ap->in[3]; \
    const float* w_ret_up = ap->in[4]; const float* w_moba_up = ap->in[5]; const float* w_out = ap->in[6]; const float* ffn_norm_w = ap->in[7]; \
    const float* w_ffn_up = ap->in[8]; const float* conv_w = ap->in[9]; const float* conv_b = ap->in[10]; const float* w_ffn_down = ap->in[11]; \
    const float* final_norm_w = ap->in[12]; \
    float* out = ap->out; \
    float* rowss1 = (float*)(ws + WS_RSS1); float* rowss2 = (float*)(ws + WS_RSS2); float* kmean = (float*)(ws + WS_KMEAN); \
    float* qk0 = (float*)(ws + WS_QK0); float* tmc = (float*)(ws + WS_TMC); float* tms = (float*)(ws + WS_TMS); float* trc = (float*)(ws + WS_TRC); float* trs = (float*)(ws + WS_TRS); \
    bf16_t* Win_t = (bf16_t*)(ws + WS_WIN); bf16_t* Wup_t = (bf16_t*)(ws + WS_WUP); bf16_t* Wdn_t = (bf16_t*)(ws + WS_WDN); \
    bf16_t* Wout_t = (bf16_t*)(ws + WS_WOUT); bf16_t* Wru_t = (bf16_t*)(ws + WS_WRU); bf16_t* Wmu_t = (bf16_t*)(ws + WS_WMU); \
    bf16_t* SEC = (bf16_t*)(ws + WS_SEC); bf16_t* GR = (bf16_t*)(ws + WS_GR); bf16_t* GM = (bf16_t*)(ws + WS_GM); \
    bf16_t* T1 = (bf16_t*)(ws + WS_T1); bf16_t* MERGED = (bf16_t*)(ws + WS_MERGED); bf16_t* X1B = (bf16_t*)(ws + WS_X1B); \
    bf16_t* UH = (bf16_t*)(ws + WS_UH); bf16_t* GH = (bf16_t*)(ws + WS_GH); bf16_t* GF = (bf16_t*)(ws + WS_GF); float* H1 = (float*)(ws + WS_H1); float* H2 = (float*)(ws + WS_H2); \
    bf16_t* Hb = (bf16_t*)out; \
    bf16_t* OMOBA = (bf16_t*)out; \
    bf16_t* ORET = (bf16_t*)out + SEC_ELEMS; \
    const int gw = bx * 8 + wave, NGW = G * 8, gt = bx * 512 + tid, NGT = G * 512;
__global__ void __launch_bounds__(512, 2) fwd_megakernel(Args args) {
    extern __shared__ __attribute__((aligned(16))) unsigned char lds_raw[];
    LAS unsigned char* lds = (LAS unsigned char*)lds_raw;
    cg::grid_group grid = cg::this_grid();
    if (threadIdx.x < 2) ((volatile LAS unsigned*)(lds + XB_ST_OFF))[threadIdx.x] = 0u;
    __syncthreads();
#ifndef SKIP_P0
    { PV;
#ifdef PROBE_P0X2
    for (int rep0_ = 0; rep0_ < 2; ++rep0_)
#endif
    {
        for (int i = gt; i < SEQ * 128; i += NGT) { const int pos = i >> 7, k = i & 127; const float inv = powf(10000.0f, -(float)(2 * k) / 256.0f), ang = (float)pos * inv;
            trc[i] = cosf(ang); trs[i] = sinf(ang); }
        for (int i = gt; i < SEQ * 16; i += NGT) { const int pos = i >> 4, k = i & 15; const float inv = powf(500000.0f, -(float)(2 * k) / 32.0f), ang = (float)pos * inv;
            tmc[i] = cosf(ang); tms[i] = sinf(ang); }
        for (int i = gt; i < XCD_BAR_WORDS; i += NGT) ((unsigned*)(ws + WS_XBAR))[i] = 0u;
        LAS float* scr = (LAS float*)(lds + wave * 16384);
        constexpr int I_IN = (DM / 64) * (NIN / 32), I_UP = I_IN, I_DN = (DFF / 64) * (DM / 32), I_OUT = (DM / 64) * (DM / 32), I_RU = (1024 / 64) * (DM / 32);
        constexpr int NITEMS = I_IN + I_UP + I_DN + I_OUT + 2 * I_RU;
#define P0_DECODE(d_, it_) do { int r = (it_); \
            if (r < I_IN) { d_ = TrItem{w_in, Win_t, nullptr, DM, NIN, r, 0}; break; } r -= I_IN; \
            if (r < I_UP) { d_ = TrItem{w_ffn_up, Wup_t, ffn_norm_w, DM, NFF, r, FUSED_FFN != 0}; break; } r -= I_UP; \
            if (r < I_DN) { d_ = TrItem{w_ffn_down, Wdn_t, nullptr, DFF, DM, r, 0}; break; } r -= I_DN; \
            if (r < I_OUT) { d_ = TrItem{w_out, Wout_t, nullptr, DM, DM, r, 0}; break; } r -= I_OUT; \
            if (r < I_RU) { d_ = TrItem{w_ret_up, Wru_t, nullptr, 1024, DM, r, 0}; break; } r -= I_RU; \
            d_ = TrItem{w_moba_up, Wmu_t, nullptr, 1024, DM, r, 0}; } while (0)
        for (int it = gw; it < NITEMS; it += 2 * NGW) { TrItem d0, d1; f32x4 v0[8], v1[8];
            P0_DECODE(d0, it); p0_tr_load(d0, lane, v0);
            const bool has1 = it + NGW < NITEMS;
            if (has1) { P0_DECODE(d1, it + NGW); p0_tr_load(d1, lane, v1); }
            p0_tr_finish(d0, lane, v0, scr);
            if (has1) p0_tr_finish(d1, lane, v1, scr); }
#undef P0_DECODE
        for (int m = gw; m < MTOK; m += NGW) {
            const f32x4* xr = (const f32x4*)(x + (size_t)m * DM) + lane; const f32x4* wr4 = (const f32x4*)attn_norm_w + lane;
            f32x4 v[8]; float s = 0.f;
#pragma unroll
            for (int j = 0; j < 8; ++j) { v[j] = xr[64 * j]; s += (v[j][0] * v[j][0] + v[j][1] * v[j][1]) + (v[j][2] * v[j][2] + v[j][3] * v[j][3]); }
            const float r = 1.f / sqrtf(wave_sum(s) * (1.f / DM) + EPS);
            u32x2* o8 = (u32x2*)(Hb + (size_t)m * DM) + lane;
#pragma unroll
            for (int j = 0; j < 8; ++j) { const f32x4 wv = wr4[64 * j]; u32x2 o; o.x = pkbf(v[j][0] * r * wv[0], v[j][1] * r * wv[1]); o.y = pkbf(v[j][2] * r * wv[2], v[j][3] * r * wv[3]); o8[64 * j] = o; } }
        __syncthreads();
      for (int it0 = bx; it0 < 32 * 4; it0 += G) { const int it = it0 & 31, tk = it0 >> 5; LAS float* hrow = (LAS float*)lds; LAS float* red = (LAS float*)(lds + 65536);
          { const f32x4* xr = (const f32x4*)(x + ((size_t)wave * SEQ + tk) * DM) + lane; const f32x4* wr4 = (const f32x4*)attn_norm_w + lane; f32x4 v[8]; float sq = 0.f;
#pragma unroll
            for (int j = 0; j < 8; ++j) { v[j] = xr[64 * j]; sq += (v[j][0] * v[j][0] + v[j][1] * v[j][1]) + (v[j][2] * v[j][2] + v[j][3] * v[j][3]); }
            const float r = 1.f / sqrtf(wave_sum(sq) * (1.f / DM) + EPS);
#pragma unroll
            for (int j = 0; j < 8; ++j) { const f32x4 wv = wr4[64 * j]; *(LAS f32x4*)(hrow + wave * 2048 + 4 * (lane + 64 * j)) = v[j] * r * wv; } }
          __syncthreads();
          const int col = tid & 63, kp = tid >> 6; const float* wp = w_in + (size_t)(kp * 256) * NIN + it * 64 + col; float a[8] = {0.f, 0.f, 0.f, 0.f, 0.f, 0.f, 0.f, 0.f};
#pragma unroll 16
          for (int k = 0; k < 256; ++k) { const float wv = wp[(size_t)k * NIN];
#pragma unroll
              for (int bb = 0; bb < 8; ++bb) a[bb] += hrow[bb * 2048 + kp * 256 + k] * wv; }
#pragma unroll
          for (int bb = 0; bb < 8; ++bb) red[(kp * 8 + bb) * 64 + col] = a[bb];
          __syncthreads();
          { const int bb = tid >> 6; float sacc = 0.f;
#pragma unroll
            for (int p = 0; p < 8; ++p) sacc += red[(p * 8 + bb) * 64 + col];
            qk0[((size_t)tk * 8 + bb) * 2048 + it * 64 + col] = sacc; }
          __syncthreads(); }
    }
    GRID_SYNC();
    { volatile LAS unsigned* st_ = (volatile LAS unsigned*)(lds + XB_ST_OFF); (void)xcd_barrier_post((unsigned*)(kargs()->ws + WS_XBAR), st_); }

    }
#endif
#ifdef PROBE_TABLES
    { PV;
      for (size_t i = gt; i < (size_t)MTOK * DM; i += NGT) { out[i] = trc[i & 262143] + 2.f * trs[i & 262143] + 4.f * tmc[i & 32767] + 8.f * tms[i & 32767]; }
      return; }
#endif
#ifdef PROBE_AFTER_P0
    { PV; const bf16_t* P = Win_t; const size_t NW = (size_t)63 * 1024 * 1024;
      for (size_t i = gt; i < (size_t)MTOK * DM; i += NGT) { float a = bflo((unsigned)P[i]); if (i + (size_t)MTOK * DM < NW) a += bflo((unsigned)P[i + (size_t)MTOK * DM]); out[i] = a; }
      return; }
#endif
#ifndef SKIP_P1
    { PV;
    { pg8::Gemm g{Hb, Win_t, MTOK, NIN, DM}; pg8::StaticOrder S; S.init(MTOK, NIN, G, bx);
#ifdef PROBE_PLAIN
      pg8::EpiPlain E{SEC, NIN};
      pg8::gemm_phase<pg8::EpiPlain, pg8::StaticOrder, GEMM_ALIGN, GEMM_SP2>(lds, g, S, E); }
#else
      pg8::EpiProj E{SEC, GR, GM, trc, trs, tmc, tms, kmean};
      pg8::gemm_phase<pg8::EpiProj, pg8::StaticOrder, GEMM_ALIGN, GEMM_SP2>(lds, g, S, E); }
#endif
    XSYNC();

    }
#endif
#ifdef PROBE_AFTER_P1
    { PV; const bf16_t* P = SEC;
      for (size_t i = gt; i < (size_t)MTOK * DM; i += NGT) { float a = 0.f; for (int j = 0; j < 11; ++j) a += bflo((unsigned)P[(size_t)j * SEC_ELEMS + (i & (SEC_ELEMS - 1))]); out[i] = a; }
      return; }
#endif
#ifndef SKIP_P2
    { PV;
#ifdef PROBE_P2X2
    for (int rep_ = 0; rep_ < 2; ++rep_)
#endif
    for (int u = bx; u < 256 + 512; u += G) {
        if (u < 256) { const int bh = u >> 3, j = u & 7, b = bh >> 2, h = bh & 3;
            const float log2g = log2f(1.0f - exp2f(-5.0f - (float)h));
            attn_unit<256, 256, false>(lds, SEC, SEC + SEC_ELEMS, SEC + 2 * SEC_ELEMS, ORET, b, h, 15 - j, ret_norm_w, SEC + 3 * SEC_ELEMS, log2g, nullptr, qk0, trc, trs);
            attn_unit<256, 256, false>(lds, SEC, SEC + SEC_ELEMS, SEC + 2 * SEC_ELEMS, ORET, b, h, j, ret_norm_w, SEC + 3 * SEC_ELEMS, log2g, nullptr, qk0, trc, trs);
        } else { const int v = u - 256, bh = v >> 3, j = v & 7, b = bh >> 3, h = bh & 7;
            attn_unit<128, 128, true>(lds, SEC + 4 * SEC_ELEMS, SEC + 5 * SEC_ELEMS, SEC + 6 * SEC_ELEMS, OMOBA, b, h, 15 - j, nullptr, nullptr, 0.f, kmean, nullptr, nullptr, nullptr);
            attn_unit<128, 128, true>(lds, SEC + 4 * SEC_ELEMS, SEC + 5 * SEC_ELEMS, SEC + 6 * SEC_ELEMS, OMOBA, b, h, j, nullptr, nullptr, 0.f, kmean, nullptr, nullptr, nullptr);
        }
    }
    __syncthreads();
    XSYNC();

    }
#endif
#ifndef SKIP_P3
    { PV;
    { pg8::Gemm g{OMOBA, Wru_t, 2 * MTOK, 2 * DM, 1024}; pg8::PairOrder S; S.init(MTOK, DM, G, bx); pg8::EpiGate2 E{GR, GM, MERGED};
      pg8::gemm_phase<pg8::EpiGate2, pg8::PairOrder, GEMM_ALIGN, GEMM_SP2>(lds, g, S, E); }
    XSYNC();

    }
#endif
#ifndef SKIP_P4
    { PV;
    { pg8::Gemm g{MERGED, Wout_t, MTOK, DM, DM}; pg8::StaticOrder S; S.init(MTOK, DM, G, bx); pg8::EpiRes E{x, out, X1B, rowss1};
      pg8::gemm_phase<pg8::EpiRes, pg8::StaticOrder, GEMM_ALIGN, GEMM_SP2>(lds, g, S, E); }
    XSYNC();

    }
#endif
#ifndef SKIP_FFN
#ifdef PROBE_AFTER_P4
    return;
#endif
#if FUSED_FFN
    { PV;
      { pg8::Gemm g{X1B, Wup_t, MTOK, NFF, DM}; pg8::StaticOrder S; S.init(MTOK, NFF, G, bx); pg8::EpiConv E{GF, rowss1, conv_w, conv_b, H1, H2, lds + 131072};
        pg8::gemm_phase<pg8::EpiConv, pg8::StaticOrder, true, GEMM_SP2>(lds, g, S, E); }
    }
    XSYNC();
    { PV;
      for (int it = gt; it < 56 * 44 * 16; it += NGT) { const int i8 = it & 15, j = (it >> 4) % 44, q = (it >> 4) / 44, pm = q + q / 7 + 1;
          const int ca = j * 256 + 8 * i8, ch = j * 128 + 8 * i8;
          const float* pA = H1 + (size_t)((pm - 1) * 2) * NFF; const float* pB = pA + NFF; const float* c0 = H2 + (size_t)(pm * 2) * NFF; const float* c1 = c0 + NFF;
#pragma unroll
          for (int hh = 0; hh < 2; ++hh) { const int ta = ca + 4 * hh, tb = ta + 128, cc = ch + 4 * hh;
              const f32x4 wa0 = *(const f32x4*)(conv_w + cc), wa1 = *(const f32x4*)(conv_w + NFF + cc), wa2 = *(const f32x4*)(conv_w + 2 * NFF + cc);
              const f32x4 wb0 = *(const f32x4*)(conv_w + DFF + cc), wb1 = *(const f32x4*)(conv_w + NFF + DFF + cc), wb2 = *(const f32x4*)(conv_w + 2 * NFF + DFF + cc);
              const f32x4 ba = *(const f32x4*)(conv_b + cc), bb = *(const f32x4*)(conv_b + DFF + cc);
              const f32x4 aA = *(const f32x4*)(pA + ta), aB = *(const f32x4*)(pB + ta), a0 = *(const f32x4*)(c0 + ta), a1 = *(const f32x4*)(c1 + ta);
              const f32x4 bA = *(const f32x4*)(pA + tb), bB = *(const f32x4*)(pB + tb), b0 = *(const f32x4*)(c0 + tb), b1 = *(const f32x4*)(c1 + tb);
              const f32x4 ya0 = ba + wa0 * aA + wa1 * aB + wa2 * a0, yb0 = bb + wb0 * bA + wb1 * bB + wb2 * b0;
              const f32x4 ya1 = ba + wa0 * aB + wa1 * a0 + wa2 * a1, yb1 = bb + wb0 * bB + wb1 * b0 + wb2 * b1;
              f32x4 g0, g1;
#pragma unroll
              for (int e = 0; e < 4; ++e) { g0[e] = ya0[e] * sigm(ya0[e]) * yb0[e]; g1[e] = ya1[e] * sigm(ya1[e]) * yb1[e]; }
              st4(GF + (size_t)(pm * 256) * DFF + cc, g0); st4(GF + (size_t)(pm * 256 + 1) * DFF + cc, g1); } }
    }
    XSYNC();
    { PV;
      { pg8::Gemm g{GF, Wdn_t, MTOK, DM, DFF}; pg8::StaticOrder S; S.init(MTOK, DM, G, bx); pg8::EpiRes E{out, out, nullptr, rowss2};
        pg8::gemm_phase<pg8::EpiRes, pg8::StaticOrder, GEMM_ALIGN, GEMM_SP2>(lds, g, S, E); }
    }
    XSYNC();
#else
    for (int half = 0; half < 2; ++half) {
#ifndef SKIP_FFN_UP
        { PV; const size_t r0 = (size_t)half * 8192;
        { pg8::Gemm g{X1B + r0 * DM, Wup_t, 8192, NFF, DM}; pg8::StaticOrder S; S.init(8192, NFF, G, bx); pg8::EpiUp E{UH, rowss1 + r0 * 32};
          pg8::gemm_phase<pg8::EpiUp, pg8::StaticOrder, GEMM_ALIGN, GEMM_SP2>(lds, g, S, E); }
        }
#endif
        XSYNC();
#ifndef SKIP_FFN_CONV
        { PV; const size_t r0 = (size_t)half * 8192;
        for (int it = gt; it < 512 * 704; it += NGT) { const int cg8 = it % 704, rc = it / 704, ch = cg8 * 8, lr0 = rc * 16;
            float wa[3][8], wb[3][8], ba[8], bb[8];
#pragma unroll
            for (int k = 0; k < 3; ++k)
#pragma unroll
                for (int e = 0; e < 8; ++e) { wa[k][e] = conv_w[k * NFF + ch + e]; wb[k][e] = conv_w[k * NFF + DFF + ch + e]; }
#pragma unroll
            for (int e = 0; e < 8; ++e) { ba[e] = conv_b[ch + e]; bb[e] = conv_b[DFF + ch + e]; }
            float a1[8], a2[8], b1[8], b2[8];
            const bool hasprev = (lr0 & (SEQ - 1)) != 0;
#pragma unroll
            for (int e = 0; e < 8; ++e) { a1[e] = 0.f; a2[e] = 0.f; b1[e] = 0.f; b2[e] = 0.f; }
            if (hasprev) { const u32x4 p2a = *(const u32x4*)(UH + (size_t)(lr0 - 2) * NFF + ch), p1a = *(const u32x4*)(UH + (size_t)(lr0 - 1) * NFF + ch);
                const u32x4 p2b = *(const u32x4*)(UH + (size_t)(lr0 - 2) * NFF + DFF + ch), p1b = *(const u32x4*)(UH + (size_t)(lr0 - 1) * NFF + DFF + ch);
#pragma unroll
                for (int e = 0; e < 4; ++e) { a2[2 * e] = bflo(p2a[e]); a2[2 * e + 1] = bfhi(p2a[e]); a1[2 * e] = bflo(p1a[e]); a1[2 * e + 1] = bfhi(p1a[e]);
                    b2[2 * e] = bflo(p2b[e]); b2[2 * e + 1] = bfhi(p2b[e]); b1[2 * e] = bflo(p1b[e]); b1[2 * e + 1] = bfhi(p1b[e]); } }
#pragma unroll 2
            for (int r = 0; r < 16; ++r) { const u32x4 ca = *(const u32x4*)(UH + (size_t)(lr0 + r) * NFF + ch), cbv = *(const u32x4*)(UH + (size_t)(lr0 + r) * NFF + DFF + ch);
                float a0[8], b0[8], gq[8];
#pragma unroll
                for (int e = 0; e < 4; ++e) { a0[2 * e] = bflo(ca[e]); a0[2 * e + 1] = bfhi(ca[e]); b0[2 * e] = bflo(cbv[e]); b0[2 * e + 1] = bfhi(cbv[e]); }
#pragma unroll
                for (int e = 0; e < 8; ++e) { const float ya = ba[e] + wa[0][e] * a2[e] + wa[1][e] * a1[e] + wa[2][e] * a0[e], yb = bb[e] + wb[0][e] * b2[e] + wb[1][e] * b1[e] + wb[2][e] * b0[e];
                    gq[e] = ya * sigm(ya) * yb; a2[e] = a1[e]; a1[e] = a0[e]; b2[e] = b1[e]; b1[e] = b0[e]; }
                u32x4 o; o.x = pkbf(gq[0], gq[1]); o.y = pkbf(gq[2], gq[3]); o.z = pkbf(gq[4], gq[5]); o.w = pkbf(gq[6], gq[7]);
                *(u32x4*)(GH + (size_t)(lr0 + r) * DFF + ch) = o; } }
        }
#endif
        XSYNC();
#ifndef SKIP_FFN_DN
        { PV; const size_t r0 = (size_t)half * 8192;
        { pg8::Gemm g{GH, Wdn_t, 8192, DM, DFF}; pg8::StaticOrder S; S.init(8192, DM, G, bx); pg8::EpiRes E{out + r0 * DM, out + r0 * DM, nullptr, rowss2 + r0 * 32};
          pg8::gemm_phase<pg8::EpiRes, pg8::StaticOrder, GEMM_ALIGN, GEMM_SP2>(lds, g, S, E); }
        }
#endif
        XSYNC();
    }
#endif

#endif
#ifndef SKIP_P8
    { PV;
    for (int m = gw; m < MTOK; m += NGW) {
        f32x4* xr = (f32x4*)(out + (size_t)m * DM) + lane; const f32x4* wr4 = (const f32x4*)final_norm_w + lane;
        const float r = 1.f / sqrtf(wave_sum(lane < 32 ? rowss2[(size_t)m * 32 + lane] : 0.f) * (1.f / DM) + EPS);
#pragma unroll
        for (int j = 0; j < 8; ++j) { const f32x4 v = xr[64 * j]; xr[64 * j] = v * r * wr4[64 * j]; }
    }
    }
#endif
}

extern "C" void kernel_launch(void* const* d_in, const int* in_sizes, int n_in, void* d_out, int out_size, void* d_ws, size_t ws_size, hipStream_t stream) {
    static int grid = 0;
    if (grid == 0) {
        if (n_in != 13 || in_sizes[0] != MTOK * DM || out_size != MTOK * DM || ws_size < WS_END) { fprintf(stderr, "kernel_launch: unexpected shapes (n_in %d, ws %zu)\n", n_in, ws_size); grid = -1; return; }
        int dev = 0, cus = 0, per_cu = 0;
        hipGetDevice(&dev); hipDeviceGetAttribute(&cus, hipDeviceAttributeMultiprocessorCount, dev);
        if (hipFuncSetAttribute((const void*)fwd_megakernel, hipFuncAttributeMaxDynamicSharedMemorySize, LDS_BYTES) != hipSuccess) { fprintf(stderr, "kernel_launch: hipFuncSetAttribute failed\n"); grid = -1; return; }
        if (hipOccupancyMaxActiveBlocksPerMultiprocessor(&per_cu, (const void*)fwd_megakernel, 512, LDS_BYTES) != hipSuccess || per_cu < 1) { fprintf(stderr, "kernel_launch: occupancy query gave %d\n", per_cu); grid = -1; return; }
        grid = cus * (per_cu > 1 ? 1 : per_cu);
    }
    if (grid < 0) return;
    Args a{};
    for (int i = 0; i < 13; ++i) a.in[i] = (const float*)d_in[i];
    a.out = (float*)d_out; a.ws = (unsigned char*)d_ws;
    void* kargs[] = {&a};
    hipError_t e = hipLaunchCooperativeKernel((const void*)fwd_megakernel, dim3(grid), dim3(512), kargs, LDS_BYTES, stream);
    if (e != hipSuccess) fprintf(stderr, "kernel_launch: cooperative launch failed: %s (grid %d)\n", hipGetErrorString(e), grid);
}
```

```cpp
#include <hip/hip_runtime.h>
#include <hip/hip_cooperative_groups.h>
#include <cstdio>
#include <cstdint>
#include <type_traits>
namespace cg = cooperative_groups;
#ifndef GEMM_ALIGN
#define GEMM_ALIGN true
#endif
#ifndef GEMM_SP2
#define GEMM_SP2 true
#endif
#ifndef FUSED_FFN
#define FUSED_FFN 1
#endif
namespace pg8 {
#define PG8_LAS __attribute__((address_space(3)))
typedef unsigned short bf16_t;
typedef short bf16x8 __attribute__((ext_vector_type(8)));
typedef float f32x4 __attribute__((ext_vector_type(4)));
typedef unsigned u32x4 __attribute__((ext_vector_type(4)));
constexpr int BM = 256, BK = 64, HALF = 128, HTB = HALF * BK * 2  , STAGE_BYTES = 8 * HTB, NXCD = 8, WGM = 2;

__host__ __device__ __forceinline__ int lds_byte(int r, int c) { const int st = (r >> 4) * 2 + (c >> 5), rr = r & 15, cc = c & 31, ob = rr * 64 + cc * 2; return st * 1024 + (ob ^ (((ob >> 9) & 1) << 5)); }
__host__ __device__ __forceinline__ void stage_rc(int b, int& R, int& C) { const int st = b / 1024, sb = b % 1024, swz = sb ^ (((sb >> 9) & 1) << 5); R = (st >> 1) * 16 + swz / 64; C = (st & 1) * 32 + (swz % 64) / 2; }
__host__ __device__ __forceinline__ int perm32(int rho) { const int n = rho >> 4, i = rho & 15; return 8 * (i >> 2) + 4 * n + (i & 3); }

struct Unit { int pm, pn; };
struct Gemm { const bf16_t* A; const bf16_t* Bt; int M, N, K; };

struct StaticOrder {
    int nM, nN, nwg, G, c;
    __host__ __device__ void init(int M, int N, int G_, int c_) { nM = M / BM; nN = N / BM; nwg = nM * nN; G = G_; c = c_; }
    __host__ __device__ bool next(int i, Unit& u) const {
        const long L = (long)i * G + c; if (L >= nwg) return false;
        int wgid = (int)L; { const int q = nwg / NXCD, r = nwg % NXCD, xcd = wgid % NXCD, off = wgid / NXCD; wgid = (xcd < r ? xcd * (q + 1) : r * (q + 1) + (xcd - r) * q) + off; }
        const int nig = WGM * nN, gid = wgid / nig, fm = gid * WGM, gsz = (nM - fm) < WGM ? (nM - fm) : WGM;
        u.pm = fm + ((wgid % nig) % gsz); u.pn = (wgid % nig) / gsz; return true;
    }
    __device__ __forceinline__ void a_ready(const Unit&) const {}
    __device__ __forceinline__ void done(const Unit&) const {}
};

__device__ __forceinline__ unsigned cvt_pk_bf16(float lo, float hi) { unsigned r; asm volatile("v_cvt_pk_bf16_f32 %0, %1, %2" : "=v"(r) : "v"(lo), "v"(hi)); return r; }
template <class E, class = void> struct epi_has_carry : std::false_type {};
template <class E> struct epi_has_carry<E, std::void_t<decltype(E::CARRY)>> : std::true_type {};
template <class Epi, class Sched, bool ALIGN_EPI = false, bool SP2 = false>
__device__ __forceinline__ void gemm_phase(PG8_LAS unsigned char* lds, const Gemm g, const Sched& S, const Epi& E) {
    int tid_ = threadIdx.x; asm volatile("" : "+v"(tid_));
    const int tid = tid_, wid = __builtin_amdgcn_readfirstlane(tid >> 6), lane = tid & 63, wr = wid >> 2, wc = wid & 3, fr = lane & 15, fq = lane >> 4;
    const int K = g.K, nt = K / BK;
    unsigned voffA[2], voffB[2];
#pragma unroll
    for (int i = 0; i < 2; ++i) { int R, C; stage_rc(tid * 16 + i * 8192, R, C); const int Rb = Epi::PERM ? ((R & ~31) + perm32(R & 31)) : R;
        voffA[i] = (unsigned)(R * K + C) * 2u; voffB[i] = (unsigned)(Rb * K + C) * 2u; }
    const size_t kstep = (size_t)(BK * 2);
    const size_t hstep = (size_t)HALF * K * 2;
    const size_t tstep = 2 * hstep;
    const unsigned ldsw = (unsigned)wid * 1024u;
    const int aoff = lds_byte(wr * 64 + fr, fq * 8), boff = lds_byte(wc * 32 + fr, fq * 8);
#define PG8_SA(b, h) (((b) * 2 + (h)) * HTB)
#define PG8_SB(b, h) ((4 + (b) * 2 + (h)) * HTB)
#define PG8_STAGE(bufoff, gbase, voff) do { _Pragma("unroll") for (int _i = 0; _i < 2; ++_i) \
        __builtin_amdgcn_global_load_lds((const unsigned*)((const char*)(gbase) + (voff)[_i]), (PG8_LAS unsigned*)(lds + (bufoff) + ldsw + _i * 8192), 16, 0, 0); } while (0)
#define PG8_LDA(dst, b, h) do { _Pragma("unroll") for (int m = 0; m < 4; ++m) _Pragma("unroll") for (int k = 0; k < 2; ++k) dst[m][k] = *(const PG8_LAS bf16x8*)(lds + PG8_SA(b, h) + aoff + m * 2048 + k * 1024); } while (0)
#define PG8_LDB(dst, b, h) do { _Pragma("unroll") for (int n = 0; n < 2; ++n) _Pragma("unroll") for (int k = 0; k < 2; ++k) dst[n][k] = *(const PG8_LAS bf16x8*)(lds + PG8_SB(b, h) + boff + n * 2048 + k * 1024); } while (0)
#define PG8_MMA(ai, bj, At, Bt) do { __builtin_amdgcn_s_setprio(1); _Pragma("unroll") for (int m = 0; m < 4; ++m) _Pragma("unroll") for (int n = 0; n < 2; ++n) _Pragma("unroll") for (int k = 0; k < 2; ++k) \
        acc[ai][bj][m][n] = __builtin_amdgcn_mfma_f32_16x16x32_bf16(Bt[n][k], At[m][k], acc[ai][bj][m][n], 0, 0, 0); __builtin_amdgcn_s_setprio(0); } while (0)
#define PG8_WAIT_V(n) asm volatile("s_waitcnt vmcnt(" #n ")" ::: "memory")
#define PG8_WAIT_L(n) asm volatile("s_waitcnt lgkmcnt(" #n ")" ::: "memory")
#define PG8_BAR __builtin_amdgcn_s_barrier()
#define PG8_SCHED __builtin_amdgcn_sched_barrier(0)
    Unit cur, nxt; int ui = 0;
    if (!S.next(0, cur)) return;
    f32x4 acc[2][2][4][2];
#pragma unroll
    for (int a = 0; a < 2; ++a)
#pragma unroll
        for (int b = 0; b < 2; ++b)
#pragma unroll
            for (int m = 0; m < 4; ++m)
#pragma unroll
                for (int n = 0; n < 2; ++n) acc[a][b][m][n] = (f32x4){0.f, 0.f, 0.f, 0.f};
    bf16x8 At[4][2], B0[2][2], B1[2][2];
    const char* cA = (const char*)g.A + (size_t)cur.pm * tstep; const char* cB = (const char*)g.Bt + (size_t)cur.pn * tstep;
    S.a_ready(cur);
    if constexpr (SP2) {
        PG8_STAGE(PG8_SB(0, 0), cB, voffB); PG8_STAGE(PG8_SB(0, 1), cB + hstep, voffB); PG8_STAGE(PG8_SA(0, 0), cA, voffA); PG8_STAGE(PG8_SA(0, 1), cA + hstep, voffA);
        if (wr == 1) PG8_BAR;
        PG8_WAIT_V(2); PG8_BAR;
        PG8_STAGE(PG8_SB(1, 0), cB + kstep, voffB); PG8_STAGE(PG8_SA(1, 0), cA + kstep, voffA); PG8_STAGE(PG8_SB(1, 1), cB + hstep + kstep, voffB);
        PG8_WAIT_V(6); PG8_BAR;
    } else {
        PG8_STAGE(PG8_SB(0, 0), cB, voffB); PG8_STAGE(PG8_SA(0, 0), cA, voffA); PG8_STAGE(PG8_SB(0, 1), cB + hstep, voffB); PG8_STAGE(PG8_SA(0, 1), cA + hstep, voffA);
        if (wr == 1) PG8_BAR;
        PG8_WAIT_V(4); PG8_BAR;
        PG8_STAGE(PG8_SB(1, 0), cB + kstep, voffB); PG8_STAGE(PG8_SA(1, 0), cA + kstep, voffA); PG8_STAGE(PG8_SB(1, 1), cB + hstep + kstep, voffB);
        PG8_WAIT_V(6); PG8_BAR;
    }
    for (;;) {
        const bool has_next = S.next(ui + 1, nxt);
        const char* nA = has_next ? (const char*)g.A + (size_t)nxt.pm * tstep : cA; const char* nB = has_next ? (const char*)g.Bt + (size_t)nxt.pn * tstep : cB;
        for (int t = 0; t < nt; t += 2) {
            const bool last = (t == nt - 2);
            const char* a1 = cA + (size_t)(t + 1) * kstep;
            const char* a2 = last ? nA : cA + (size_t)(t + 2) * kstep; const char* b2 = last ? nB : cB + (size_t)(t + 2) * kstep;
            const char* a3 = a2 + kstep; const char* b3 = b2 + kstep;
            if (last && has_next) S.a_ready(nxt);
            if constexpr (SP2) {
            PG8_LDB(B0, 0, 0); PG8_LDB(B1, 0, 1); PG8_SCHED; PG8_LDA(At, 0, 0); PG8_STAGE(PG8_SA(1, 1), a1 + hstep, voffA);
            PG8_WAIT_V(8); PG8_WAIT_L(0); PG8_BAR; PG8_MMA(0, 0, At, B0); PG8_MMA(0, 1, At, B1); PG8_BAR; PG8_SCHED;
            PG8_LDA(At, 0, 1); PG8_STAGE(PG8_SB(0, 0), b2, voffB); PG8_STAGE(PG8_SB(0, 1), b2 + hstep, voffB); PG8_STAGE(PG8_SA(0, 0), a2, voffA);
            PG8_WAIT_V(8); PG8_WAIT_L(0); PG8_BAR; PG8_MMA(1, 0, At, B0); PG8_MMA(1, 1, At, B1); PG8_BAR; PG8_SCHED;
            PG8_LDB(B0, 1, 0); PG8_LDB(B1, 1, 1); PG8_SCHED; PG8_LDA(At, 1, 0); PG8_STAGE(PG8_SA(0, 1), a2 + hstep, voffA);
            PG8_WAIT_V(8); PG8_WAIT_L(0); PG8_BAR; PG8_MMA(0, 0, At, B0); PG8_MMA(0, 1, At, B1); PG8_BAR; PG8_SCHED;
            PG8_LDA(At, 1, 1); PG8_STAGE(PG8_SB(1, 0), b3, voffB); PG8_STAGE(PG8_SB(1, 1), b3 + hstep, voffB); PG8_STAGE(PG8_SA(1, 0), a3, voffA);
            PG8_WAIT_V(8); PG8_WAIT_L(0); PG8_BAR; PG8_MMA(1, 0, At, B0); PG8_MMA(1, 1, At, B1); PG8_BAR; PG8_SCHED;
            } else {
            PG8_LDB(B0, 0, 0); PG8_SCHED; PG8_LDA(At, 0, 0); PG8_STAGE(PG8_SA(1, 1), a1 + hstep, voffA);
            PG8_WAIT_L(8); PG8_BAR; PG8_WAIT_L(0); PG8_MMA(0, 0, At, B0); PG8_BAR; PG8_SCHED;
            PG8_LDB(B1, 0, 1); PG8_STAGE(PG8_SB(0, 0), b2, voffB);
            PG8_BAR; PG8_WAIT_L(0); PG8_MMA(0, 1, At, B1); PG8_BAR;
            PG8_LDA(At, 0, 1); PG8_STAGE(PG8_SA(0, 0), a2, voffA);
            PG8_BAR; PG8_WAIT_L(0); PG8_MMA(1, 0, At, B0); PG8_BAR; PG8_SCHED;
            PG8_STAGE(PG8_SB(0, 1), b2 + hstep, voffB);
            PG8_WAIT_V(6); PG8_BAR; PG8_MMA(1, 1, At, B1); PG8_BAR;
            PG8_LDB(B0, 1, 0); PG8_SCHED; PG8_LDA(At, 1, 0); PG8_STAGE(PG8_SA(0, 1), a2 + hstep, voffA);
            PG8_WAIT_L(8); PG8_BAR; PG8_WAIT_L(0); PG8_MMA(0, 0, At, B0); PG8_BAR; PG8_SCHED;
            PG8_LDB(B1, 1, 1); PG8_STAGE(PG8_SB(1, 0), b3, voffB);
            PG8_BAR; PG8_WAIT_L(0); PG8_MMA(0, 1, At, B1); PG8_BAR;
            PG8_LDA(At, 1, 1); PG8_STAGE(PG8_SA(1, 0), a3, voffA);
            PG8_BAR; PG8_WAIT_L(0); PG8_MMA(1, 0, At, B0); PG8_BAR; PG8_SCHED;
            PG8_STAGE(PG8_SB(1, 1), b3 + hstep, voffB);
            PG8_WAIT_V(6); PG8_BAR; PG8_MMA(1, 1, At, B1); PG8_BAR;
            }
        }
        if constexpr (ALIGN_EPI) { if (wr == 0) PG8_BAR; }
        if constexpr (!Epi::AFTER_DRAIN) { E(acc, cur, wr, wc, fr, fq); S.done(cur); }
        if (!has_next) break;
        bool keep_acc = false; if constexpr (epi_has_carry<Epi>::value) keep_acc = E.keep(cur);
        if (!keep_acc) {
#pragma unroll
        for (int a = 0; a < 2; ++a)
#pragma unroll
            for (int b = 0; b < 2; ++b)
#pragma unroll
                for (int m = 0; m < 4; ++m)
#pragma unroll
                    for (int n = 0; n < 2; ++n) acc[a][b][m][n] = (f32x4){0.f, 0.f, 0.f, 0.f};
        }
        cur = nxt; cA = nA; cB = nB; ++ui;
        if constexpr (ALIGN_EPI) { if (wr == 1) PG8_BAR; }
    }
    PG8_WAIT_V(0);
    if constexpr (!ALIGN_EPI) { if (wr == 0) PG8_BAR; }
    PG8_BAR;
    if constexpr (Epi::AFTER_DRAIN) { E.fused(acc, cur, wr, wc, fr, fq, lds, wid, lane); S.done(cur); }
#undef PG8_SA
#undef PG8_SB
#undef PG8_STAGE
#undef PG8_LDA
#undef PG8_LDB
#undef PG8_MMA
#undef PG8_WAIT_V
#undef PG8_WAIT_L
#undef PG8_BAR
#undef PG8_SCHED
}
}

#define LAS __attribute__((address_space(3)))
typedef unsigned short bf16_t;
typedef short bf16x8 __attribute__((ext_vector_type(8)));
typedef float f32x4 __attribute__((ext_vector_type(4)));
typedef unsigned u32x4 __attribute__((ext_vector_type(4)));
typedef unsigned u32x2 __attribute__((ext_vector_type(2)));

constexpr int MTOK = 16384, SEQ = 2048, DM = 2048, NIN = 11264, DFF = 5632, NFF = 11264;
constexpr float EPS = 1e-6f;
constexpr size_t MiB = 1u << 20;
constexpr size_t WS_RSS1 = 500 * MiB, WS_RSS2 = 504 * MiB,
                  WS_KMEAN = 3 * MiB  , WS_TMC = 384 * 1024, WS_TMS = 512 * 1024, WS_QK0 = 640 * 1024  , WS_TRC = 1 * MiB, WS_TRS = 2 * MiB;
constexpr size_t WS_WIN = 4 * MiB, WS_WUP = 48 * MiB, WS_WDN = 92 * MiB, WS_WOUT = 114 * MiB, WS_WRU = 122 * MiB, WS_WMU = 126 * MiB;
constexpr size_t WS_SEC = 130 * MiB;
constexpr size_t WS_GR = 354 * MiB, WS_GM = 418 * MiB;
constexpr size_t WS_T1 = 130 * MiB, WS_MERGED = 194 * MiB, WS_X1B = 258 * MiB;
constexpr size_t WS_UH = 322 * MiB, WS_GH = 130 * MiB;
constexpr size_t WS_GF = 322 * MiB, WS_H1 = 130 * MiB, WS_H2 = 136 * MiB;
constexpr size_t WS_XBAR = 900 * 1024;
constexpr int XB_ST_OFF = 141312;
constexpr size_t WS_END = 512 * MiB;
constexpr size_t SEC_ELEMS = (size_t)MTOK * 1024;
constexpr int LDS_BYTES = 147456;
constexpr float QSCALE = 0.08838834764831845f * 1.4426950408889634f;

__device__ __forceinline__ float bflo(unsigned w) { return __uint_as_float(w << 16); }
__device__ __forceinline__ float bfhi(unsigned w) { return __uint_as_float(w & 0xffff0000u); }
__device__ __forceinline__ float ex2(float v) { return __builtin_amdgcn_exp2f(v); }
__device__ __forceinline__ float sigm(float v) { return __builtin_amdgcn_rcpf(1.f + ex2(-1.4426950408889634f * v)); }
typedef float f32x2_t __attribute__((ext_vector_type(2))); typedef __bf16 bf16x2_t __attribute__((ext_vector_type(2)));
__device__ __forceinline__ unsigned pkbf(float lo, float hi) {
#ifdef PROBE_JITTER
    lo *= PROBE_JITTER_A; hi *= PROBE_JITTER_B;
#endif
    f32x2_t v = {lo, hi}; bf16x2_t b = __builtin_convertvector(v, bf16x2_t); return __builtin_bit_cast(unsigned, b); }
__device__ __forceinline__ void st4(bf16_t* p, f32x4 v) { u32x2 w; w.x = pkbf(v[0], v[1]); w.y = pkbf(v[2], v[3]); *(u32x2*)p = w; }

namespace pg8 {
struct EpiProj {
    static constexpr bool PERM = true, AFTER_DRAIN = false;
    bf16_t* sec; bf16_t* gr; bf16_t* gm; const float* rc; const float* rs; const float* mc; const float* ms; float* kpart;
    static __device__ __forceinline__ void st8(bf16_t* p, const f32x4& a, const f32x4& b) { u32x4 w; w.x = pkbf(a[0], a[1]); w.y = pkbf(a[2], a[3]); w.z = pkbf(b[0], b[1]); w.w = pkbf(b[2], b[3]); *(u32x4*)p = w; }
    __device__ __forceinline__ void operator()(const f32x4 (&acc)[2][2][4][2], const Unit& u, int wr, int wc, int fr, int fq) const {
        const int pn = u.pn, row0 = u.pm * BM + wr * 64 + fr;
        if (pn < 28) {
            const int s = pn >> 2;
            bf16_t* base = sec + (size_t)s * SEC_ELEMS + (pn & 3) * 256 + wc * 32 + fq * 8;
            if (s <= 1) {
                const float sc = s == 1 ? 0.0625f : 1.f;
#pragma unroll
                for (int ai = 0; ai < 2; ++ai)
#pragma unroll
                    for (int m = 0; m < 4; ++m) { const int row = row0 + ai * HALF + m * 16, pos = row & (SEQ - 1); bf16_t* rowp = base + (size_t)row * 1024;
                        const int ti = pos * 128 + wc * 32 + fq * 8;
                        const f32x4 c0 = *(const f32x4*)(rc + ti), c1 = *(const f32x4*)(rc + ti + 4), s0 = *(const f32x4*)(rs + ti), s1 = *(const f32x4*)(rs + ti + 4);
                        const f32x4 a0 = acc[ai][0][m][0], a1 = acc[ai][0][m][1], b0 = acc[ai][1][m][0], b1 = acc[ai][1][m][1];
                        st8(rowp, (a0 * c0 - b0 * s0) * sc, (a1 * c1 - b1 * s1) * sc); st8(rowp + HALF, (b0 * c0 + a0 * s0) * sc, (b1 * c1 + a1 * s1) * sc); asm volatile("" ::: "memory"); }
            } else if (s == 4 || s == 5) {
                const float sc = s == 4 ? QSCALE : 1.f;
#pragma unroll
                for (int bj = 0; bj < 2; ++bj) { f32x4 cs0 = {0.f, 0.f, 0.f, 0.f}, cs1 = cs0;
                    int row0b = row0; asm volatile("" : "+v"(row0b));
#pragma unroll
                    for (int ai = 0; ai < 2; ++ai)
#pragma unroll
                        for (int m = 0; m < 4; ++m) { const int row = row0b + ai * HALF + m * 16, pos = row & (SEQ - 1); bf16_t* rowp = base + (size_t)row * 1024;
                            f32x4 o0 = acc[ai][bj][m][0], o1 = acc[ai][bj][m][1];
                            if (wc == 0) { const int ti = pos * 16 + (fq & 1) * 8; const f32x4 c0 = *(const f32x4*)(mc + ti), c1 = *(const f32x4*)(mc + ti + 4);
                                f32x4 s0 = *(const f32x4*)(ms + ti), s1 = *(const f32x4*)(ms + ti + 4); if (fq < 2) { s0 = -s0; s1 = -s1; }
                                f32x4 p0, p1;
#pragma unroll
                                for (int jj = 0; jj < 4; ++jj) { p0[jj] = __shfl_xor(o0[jj], 32); p1[jj] = __shfl_xor(o1[jj], 32); }
                                o0 = o0 * c0 + p0 * s0; o1 = o1 * c1 + p1 * s1; }
                            o0 *= sc; o1 *= sc; st8(rowp + bj * HALF, o0, o1); if (s == 5) { cs0 += o0; cs1 += o1; } asm volatile("" ::: "memory"); }
                    if (s == 5) {
#pragma unroll
                        for (int jj = 0; jj < 4; ++jj) { float v = cs0[jj]; v += __shfl_xor(v, 1); v += __shfl_xor(v, 2); v += __shfl_xor(v, 4); v += __shfl_xor(v, 8); cs0[jj] = v;
                            float w2 = cs1[jj]; w2 += __shfl_xor(w2, 1); w2 += __shfl_xor(w2, 2); w2 += __shfl_xor(w2, 4); w2 += __shfl_xor(w2, 8); cs1[jj] = w2; }
                        if (fr == 0) { float* kp = kpart + (size_t)(u.pm * 2 + wr) * 1024 + (pn & 3) * 256 + bj * HALF + wc * 32 + fq * 8; *(f32x4*)kp = cs0; *(f32x4*)(kp + 4) = cs1; } }
                    asm volatile("" ::: "memory"); }
            } else {
#pragma unroll
                for (int ai = 0; ai < 2; ++ai)
#pragma unroll
                    for (int m = 0; m < 4; ++m) { const int row = row0 + ai * HALF + m * 16; bf16_t* rowp = base + (size_t)row * 1024;
#pragma unroll
                        for (int bj = 0; bj < 2; ++bj) { f32x4 v0 = acc[ai][bj][m][0], v1 = acc[ai][bj][m][1];
                            if (s == 3) {
#pragma unroll
                                for (int jj = 0; jj < 4; ++jj) { v0[jj] *= sigm(v0[jj]); v1[jj] *= sigm(v1[jj]); } }
                            st8(rowp + bj * HALF, v0, v1); } }
            }
        } else {
            bf16_t* base = (pn < 36 ? gr : gm) + ((pn - 28) & 7) * 256 + wc * 32 + fq * 8;
#pragma unroll
            for (int ai = 0; ai < 2; ++ai)
#pragma unroll
                for (int m = 0; m < 4; ++m) { const int row = row0 + ai * HALF + m * 16; bf16_t* rowp = base + (size_t)row * DM;
#pragma unroll
                    for (int bj = 0; bj < 2; ++bj) { f32x4 v0 = acc[ai][bj][m][0], v1 = acc[ai][bj][m][1];
#pragma unroll
                        for (int jj = 0; jj < 4; ++jj) { v0[jj] = sigm(v0[jj]); v1[jj] = sigm(v1[jj]); }
                        st8(rowp + bj * HALF, v0, v1); } }
        }
    }
};
struct PairOrder {
    StaticOrder base;
    __device__ void init(int M, int N, int G_, int c_) { base.init(M, N, G_, c_); }
    __device__ bool next(int i, Unit& u) const { Unit t; if (!base.next(i >> 1, t)) return false; if (i & 1) { u.pm = t.pm; u.pn = t.pn + 8; } else { u.pm = t.pm + 64; u.pn = t.pn; } return true; }
    __device__ __forceinline__ void a_ready(const Unit&) const {}
    __device__ __forceinline__ void done(const Unit&) const {}
};
struct EpiGate2 {
    static constexpr bool PERM = true, AFTER_DRAIN = false, CARRY = true;
    const bf16_t* gr; const bf16_t* gm; bf16_t* O;
    __device__ __forceinline__ bool keep(const Unit& u) const { return u.pn < 8; }
    __device__ __forceinline__ void operator()(const f32x4 (&acc)[2][2][4][2], const Unit& u, int wr, int wc, int fr, int fq) const {
        const bool ret = u.pn < 8; const int row0 = (u.pm & 63) * BM + wr * 64 + fr, col0 = (u.pn & 7) * BM + wc * 32 + 8 * fq;
        f32x4 (&A)[2][2][4][2] = const_cast<f32x4 (&)[2][2][4][2]>(acc);
#pragma unroll
        for (int ai = 0; ai < 2; ++ai)
#pragma unroll
            for (int m = 0; m < 4; ++m) { const size_t ro = (size_t)(row0 + ai * HALF + m * 16) * DM + col0;
#pragma unroll
                for (int bj = 0; bj < 2; ++bj) { const size_t off = ro + bj * HALF; const u32x4 g2 = *(const u32x4*)(gm + off);
                    if (ret) { const u32x4 g1 = *(const u32x4*)(gr + off);
                        A[ai][bj][m][0][0] *= bflo(g1.x) * __builtin_amdgcn_rcpf(bflo(g2.x)); A[ai][bj][m][0][1] *= bfhi(g1.x) * __builtin_amdgcn_rcpf(bfhi(g2.x));
                        A[ai][bj][m][0][2] *= bflo(g1.y) * __builtin_amdgcn_rcpf(bflo(g2.y)); A[ai][bj][m][0][3] *= bfhi(g1.y) * __builtin_amdgcn_rcpf(bfhi(g2.y));
                        A[ai][bj][m][1][0] *= bflo(g1.z) * __builtin_amdgcn_rcpf(bflo(g2.z)); A[ai][bj][m][1][1] *= bfhi(g1.z) * __builtin_amdgcn_rcpf(bfhi(g2.z));
                        A[ai][bj][m][1][2] *= bflo(g1.w) * __builtin_amdgcn_rcpf(bflo(g2.w)); A[ai][bj][m][1][3] *= bfhi(g1.w) * __builtin_amdgcn_rcpf(bfhi(g2.w));
                    } else { const f32x4 v0 = acc[ai][bj][m][0], v1 = acc[ai][bj][m][1];
                        u32x4 w; w.x = pkbf(v0[0] * bflo(g2.x), v0[1] * bfhi(g2.x)); w.y = pkbf(v0[2] * bflo(g2.y), v0[3] * bfhi(g2.y));
                        w.z = pkbf(v1[0] * bflo(g2.z), v1[1] * bfhi(g2.z)); w.w = pkbf(v1[2] * bflo(g2.w), v1[3] * bfhi(g2.w));
                        *(u32x4*)(O + off) = w; } }
                if (m == 3) asm volatile("" ::: "memory"); }
    }
};
struct EpiGate {
    static constexpr bool PERM = true, AFTER_DRAIN = false;
    const bf16_t* gate; const bf16_t* addsrc; bf16_t* O;
    __device__ __forceinline__ void operator()(const f32x4 (&acc)[2][2][4][2], const Unit& u, int wr, int wc, int fr, int fq) const {
        const int row0 = u.pm * BM + wr * 64 + fr, col0 = u.pn * BM + wc * 32 + 8 * fq;
#pragma unroll
        for (int ai = 0; ai < 2; ++ai)
#pragma unroll
            for (int m = 0; m < 4; ++m) { const size_t ro = (size_t)(row0 + ai * HALF + m * 16) * DM + col0;
#pragma unroll
                for (int bj = 0; bj < 2; ++bj) { const size_t off = ro + bj * HALF; const u32x4 g = *(const u32x4*)(gate + off);
                    const f32x4 v0 = acc[ai][bj][m][0], v1 = acc[ai][bj][m][1];
                    float r0 = v0[0] * bflo(g.x), r1 = v0[1] * bfhi(g.x), r2 = v0[2] * bflo(g.y), r3 = v0[3] * bfhi(g.y);
                    float r4 = v1[0] * bflo(g.z), r5 = v1[1] * bfhi(g.z), r6 = v1[2] * bflo(g.w), r7 = v1[3] * bfhi(g.w);
                    if (addsrc) { const u32x4 t = *(const u32x4*)(addsrc + off);
                        r0 += bflo(t.x); r1 += bfhi(t.x); r2 += bflo(t.y); r3 += bfhi(t.y); r4 += bflo(t.z); r5 += bfhi(t.z); r6 += bflo(t.w); r7 += bfhi(t.w); }
                    u32x4 w; w.x = pkbf(r0, r1); w.y = pkbf(r2, r3); w.z = pkbf(r4, r5); w.w = pkbf(r6, r7);
                    *(u32x4*)(O + off) = w; } }
    }
};
struct EpiRes {
    static constexpr bool PERM = true, AFTER_DRAIN = false;
    const float* xi; float* xo; bf16_t* xb; float* rowss;
    __device__ __forceinline__ void operator()(const f32x4 (&acc)[2][2][4][2], const Unit& u, int wr, int wc, int fr, int fq) const {
        const int row0 = u.pm * BM + wr * 64 + fr, col0 = u.pn * BM + wc * 32 + 8 * fq;
#pragma unroll
        for (int ai = 0; ai < 2; ++ai)
#pragma unroll
            for (int m = 0; m < 4; ++m) { const int row = row0 + ai * HALF + m * 16; const size_t ro = (size_t)row * DM + col0; float ss = 0.f;
#pragma unroll
                for (int bj = 0; bj < 2; ++bj) { const size_t off = ro + bj * HALF;
                    f32x4 a0 = *(const f32x4*)(xi + off), a1 = *(const f32x4*)(xi + off + 4);
                    a0 += acc[ai][bj][m][0]; a1 += acc[ai][bj][m][1];
                    *(f32x4*)(xo + off) = a0; *(f32x4*)(xo + off + 4) = a1;
                    if (xb) { u32x4 w; w.x = pkbf(a0[0], a0[1]); w.y = pkbf(a0[2], a0[3]); w.z = pkbf(a1[0], a1[1]); w.w = pkbf(a1[2], a1[3]); *(u32x4*)(xb + off) = w; }
                    ss += (a0[0] * a0[0] + a0[1] * a0[1]) + (a0[2] * a0[2] + a0[3] * a0[3]) + (a1[0] * a1[0] + a1[1] * a1[1]) + (a1[2] * a1[2] + a1[3] * a1[3]); }
                ss += __shfl_xor(ss, 16); ss += __shfl_xor(ss, 32);
                if (fq == 0) rowss[(size_t)row * 32 + u.pn * 4 + wc] = ss; }
    }
};
#ifndef PLAIN_PERM
#define PLAIN_PERM true
#endif
struct EpiPlain {
    static constexpr bool PERM = PLAIN_PERM, AFTER_DRAIN = false;
    bf16_t* U; int ld;
    __device__ __forceinline__ void operator()(const f32x4 (&acc)[2][2][4][2], const Unit& u, int wr, int wc, int fr, int fq) const {
        const int row0 = u.pm * BM + wr * 64 + fr, col0 = u.pn * BM + wc * 32 + 8 * fq;
#pragma unroll
        for (int ai = 0; ai < 2; ++ai)
#pragma unroll
            for (int m = 0; m < 4; ++m) { const int row = row0 + ai * HALF + m * 16; bf16_t* rowp = U + (size_t)row * ld + col0;
#pragma unroll
                for (int bj = 0; bj < 2; ++bj) { const f32x4 v0 = acc[ai][bj][m][0], v1 = acc[ai][bj][m][1];
                    u32x4 w; w.x = pkbf(v0[0], v0[1]); w.y = pkbf(v0[2], v0[3]); w.z = pkbf(v1[0], v1[1]); w.w = pkbf(v1[2], v1[3]);
                    *(u32x4*)(rowp + bj * HALF) = w; } }
    }
};
struct EpiUp {
    static constexpr bool PERM = true, AFTER_DRAIN = false;
    bf16_t* U; const float* rowss;
    __device__ __forceinline__ void operator()(const f32x4 (&acc)[2][2][4][2], const Unit& u, int wr, int wc, int fr, int fq) const {
        const int row0 = u.pm * BM + wr * 64 + fr, col0 = u.pn * BM + wc * 32 + 8 * fq;
#pragma unroll
        for (int ai = 0; ai < 2; ++ai)
#pragma unroll
            for (int m = 0; m < 4; ++m) { const int row = row0 + ai * HALF + m * 16; const float* pp = rowss + (size_t)row * 32 + 8 * fq; const f32x4 p0 = *(const f32x4*)pp, p1 = *(const f32x4*)(pp + 4);
                float sq = ((p0[0] + p0[1]) + (p0[2] + p0[3])) + ((p1[0] + p1[1]) + (p1[2] + p1[3])); sq += __shfl_xor(sq, 16); sq += __shfl_xor(sq, 32);
                const float r = __builtin_amdgcn_rsqf(sq * (1.f / DM) + EPS);
                bf16_t* rowp = U + (size_t)row * NFF + col0;
#pragma unroll
                for (int bj = 0; bj < 2; ++bj) { const f32x4 v0 = acc[ai][bj][m][0] * r, v1 = acc[ai][bj][m][1] * r;
                    u32x4 w; w.x = pkbf(v0[0], v0[1]); w.y = pkbf(v0[2], v0[3]); w.z = pkbf(v1[0], v1[1]); w.w = pkbf(v1[2], v1[3]);
                    *(u32x4*)(rowp + bj * HALF) = w; } }
    }
};

__device__ __forceinline__ float dpp_ror1(float v) { return __builtin_bit_cast(float, __builtin_amdgcn_mov_dpp(__builtin_bit_cast(int, v), 0x121, 0xf, 0xf, true)); }
__device__ __forceinline__ float dpp_ror2(float v) { return __builtin_bit_cast(float, __builtin_amdgcn_mov_dpp(__builtin_bit_cast(int, v), 0x122, 0xf, 0xf, true)); }
struct EpiConv {
    static constexpr bool PERM = true, AFTER_DRAIN = false;
    bf16_t* G; const float* rowss; const float* cw; const float* cbias; float* H1; float* H2; PG8_LAS unsigned char* xl;
    __device__ __forceinline__ void operator()(const f32x4 (&acc)[2][2][4][2], const Unit& u, int wr, int wc, int fr_, int fq_) const {
        int ln_ = threadIdx.x & 63; asm volatile("" : "+v"(ln_)); const int fr = ln_ & 15, fq = ln_ >> 4; (void)fr_; (void)fq_;

        const int row0 = u.pm * BM + wr * 64 + fr, ch0 = u.pn * 128 + wc * 32 + 8 * fq, tc0 = u.pn * 256 + wc * 32 + 8 * fq;
        f32x4 (&A)[2][2][4][2] = const_cast<f32x4 (&)[2][2][4][2]>(acc);
        PG8_LAS float* rs = (PG8_LAS float*)(xl + 8192);
        { const int t = threadIdx.x; if (t < 256) { const f32x4* pp = (const f32x4*)(rowss + (size_t)(u.pm * BM + t) * 32); float sq = 0.f;
#pragma unroll
              for (int q = 0; q < 8; ++q) { const f32x4 p = pp[q]; sq += (p[0] + p[1]) + (p[2] + p[3]); }
              rs[t] = __builtin_amdgcn_rsqf(sq * (1.f / DM) + EPS); } }
        asm volatile("s_waitcnt lgkmcnt(0)" ::: "memory"); __builtin_amdgcn_s_barrier(); asm volatile("" ::: "memory");
#pragma unroll
        for (int ai = 0; ai < 2; ++ai)
#pragma unroll
            for (int m = 0; m < 4; ++m) { const float rr = rs[ai * HALF + wr * 64 + m * 16 + fr];
                A[ai][0][m][0] *= rr; A[ai][0][m][1] *= rr; A[ai][1][m][0] *= rr; A[ai][1][m][1] *= rr; }
        PG8_LAS f32x4* X = (PG8_LAS f32x4*)xl;
        if (fr >= 14) {
#pragma unroll
            for (int ai = 0; ai < 2; ++ai)
#pragma unroll
                for (int bj = 0; bj < 2; ++bj)
#pragma unroll
                    for (int n = 0; n < 2; ++n) X[(((((ai * 2 + wr) * 4 + wc) * 2 + (fr - 14)) * 4 + fq) * 4) + bj * 2 + n] = A[ai][bj][3][n];
            if (wr == 1) {
#pragma unroll
                for (int bj = 0; bj < 2; ++bj)
#pragma unroll
                    for (int n = 0; n < 2; ++n) *(f32x4*)(H1 + (size_t)(u.pm * 2 + (fr - 14)) * NFF + tc0 + bj * HALF + 4 * n) = A[1][bj][3][n]; }
        }
        if (wr == 0 && fr < 2) {
#pragma unroll
            for (int bj = 0; bj < 2; ++bj)
#pragma unroll
                for (int n = 0; n < 2; ++n) *(f32x4*)(H2 + (size_t)(u.pm * 2 + fr) * NFF + tc0 + bj * HALF + 4 * n) = A[0][bj][0][n]; }
        asm volatile("s_waitcnt lgkmcnt(0)" ::: "memory"); __builtin_amdgcn_s_barrier(); asm volatile("" ::: "memory");
#pragma unroll
        for (int n = 0; n < 2; ++n)
#pragma unroll
            for (int ai = 0; ai < 2; ++ai) {
                const bool hasprev = (wr == 1 || ai == 1); const int sai = wr == 1 ? ai : 0, swr = wr == 1 ? 0 : 1, base = ((sai * 2 + swr) * 4 + wc) * 2;
                const int i1 = ((base + 1) * 4 + fq) * 4 + n, i2 = ((base + (fr & 1)) * 4 + fq) * 4 + n;
                f32x4 sa[4];
                { const float* cwp = cw + ch0 + 4 * n; const f32x4 w0 = *(const f32x4*)cwp, w1 = *(const f32x4*)(cwp + NFF), w2 = *(const f32x4*)(cwp + 2 * NFF), bv = *(const f32x4*)(cbias + ch0 + 4 * n);
                  f32x4 P1 = {0.f, 0.f, 0.f, 0.f}, P2 = P1; if (hasprev) { P1 = X[i1]; P2 = X[i2]; }
#pragma unroll
                  for (int m = 0; m < 4; ++m) { const f32x4 c = A[ai][0][m][n]; f32x4 R1, R2;
#pragma unroll
                      for (int jj = 0; jj < 4; ++jj) { R1[jj] = dpp_ror1(c[jj]); R2[jj] = dpp_ror2(c[jj]); }
                      const f32x4 p1 = fr >= 1 ? R1 : P1, p2 = fr >= 2 ? R2 : P2; const f32x4 y = bv + w0 * p2 + w1 * p1 + w2 * c;
                      sa[m][0] = y[0] * sigm(y[0]); sa[m][1] = y[1] * sigm(y[1]); sa[m][2] = y[2] * sigm(y[2]); sa[m][3] = y[3] * sigm(y[3]); P1 = R1; P2 = R2; } }
                asm volatile("" ::: "memory");
                { const float* cwp = cw + DFF + ch0 + 4 * n; const f32x4 w0 = *(const f32x4*)cwp, w1 = *(const f32x4*)(cwp + NFF), w2 = *(const f32x4*)(cwp + 2 * NFF), bv = *(const f32x4*)(cbias + DFF + ch0 + 4 * n);
                  f32x4 P1 = {0.f, 0.f, 0.f, 0.f}, P2 = P1; if (hasprev) { P1 = X[i1 + 2]; P2 = X[i2 + 2]; }
#pragma unroll
                  for (int m = 0; m < 4; ++m) { const f32x4 c = A[ai][1][m][n]; f32x4 R1, R2;
#pragma unroll
                      for (int jj = 0; jj < 4; ++jj) { R1[jj] = dpp_ror1(c[jj]); R2[jj] = dpp_ror2(c[jj]); }
                      const f32x4 p1 = fr >= 1 ? R1 : P1, p2 = fr >= 2 ? R2 : P2; const f32x4 y = bv + w0 * p2 + w1 * p1 + w2 * c;
                      st4(G + (size_t)(row0 + ai * HALF + m * 16) * DFF + ch0 + 4 * n, sa[m] * y); P1 = R1; P2 = R2; } }
                asm volatile("" ::: "memory");
            }
    }
};
}

__device__ __forceinline__ float wave_sum(float v) {
#pragma unroll
    for (int o = 1; o < 64; o <<= 1) v += __shfl_xor(v, o);
    return v;
}
template <int DK, int DV, bool SOFTMAX>
__device__ __forceinline__ void attn_unit(LAS unsigned char* lds, const bf16_t* Qg, const bf16_t* Kg, const bf16_t* Vg, bf16_t* Og, int b, int h, int qt,
                                          const float* normw, const bf16_t* rgate, float log2g, const float* kmean, const float* qk0, const float* trc, const float* trs) {
    constexpr int KST = (DK + 8) * 2, VST = 144, KS_OFF = 0, VT_OFF = 64 * KST, LIST_OFF = VT_OFF + DV * VST, NS = DK / 32, NT = DV / 16;
    constexpr int NKC = (64 * DK / 8) / 512, NVC = (32 * DV / 8) / 512;
    const int tid = threadIdx.x, w = __builtin_amdgcn_readfirstlane(tid >> 6), lane = tid & 63, c = lane & 15, kq = lane >> 4;
    const int t0 = qt * 128, cb = t0 >> 8, qi = t0 + 16 * w + c;
    const size_t rowbase = (size_t)b * SEQ;
    LAS int* list = (LAS int*)(lds + LIST_OFF);
    bf16x8 bq[NS];
    { const bf16_t* qp = Qg + (rowbase + qi) * 1024 + h * DK + 8 * kq;
#pragma unroll
      for (int s = 0; s < NS; ++s) bq[s] = *(const bf16x8*)(qp + 32 * s); }
    unsigned selmask = 0u;
    __syncthreads();
    if constexpr (SOFTMAX) {
        float bs[7];
#pragma unroll
        for (int n = 0; n < 7; ++n) { bs[n] = -INFINITY;
            if (n < cb) { const float* km = kmean + (size_t)((b * 8 + n) * 2) * 1024 + h * 128 + 8 * kq; float a = 0.f;
#pragma unroll
                for (int s = 0; s < NS; ++s) { const f32x4 k0v = *(const f32x4*)(km + 32 * s) + *(const f32x4*)(km + 1024 + 32 * s), k1v = *(const f32x4*)(km + 32 * s + 4) + *(const f32x4*)(km + 1024 + 32 * s + 4);
                    a += __uint_as_float((unsigned)(unsigned short)bq[s][0] << 16) * k0v[0] + __uint_as_float((unsigned)(unsigned short)bq[s][1] << 16) * k0v[1]
                       + __uint_as_float((unsigned)(unsigned short)bq[s][2] << 16) * k0v[2] + __uint_as_float((unsigned)(unsigned short)bq[s][3] << 16) * k0v[3]
                       + __uint_as_float((unsigned)(unsigned short)bq[s][4] << 16) * k1v[0] + __uint_as_float((unsigned)(unsigned short)bq[s][5] << 16) * k1v[1]
                       + __uint_as_float((unsigned)(unsigned short)bq[s][6] << 16) * k1v[2] + __uint_as_float((unsigned)(unsigned short)bq[s][7] << 16) * k1v[3]; }
                a += __shfl_xor(a, 16); a += __shfl_xor(a, 32); bs[n] = a;
#ifdef PROBE_NOISE
                bs[n] += 0.002f * (float)(((unsigned)(qi * 7 + n * 13 + h * 5 + b * 3) * 2654435761u >> 24) & 255u) * (1.f / 256.f);
#endif
            } }
        if (cb <= 3) selmask = (1u << cb) - 1u;
        else {
#pragma unroll
            for (int pick = 0; pick < 3; ++pick) { float best = -INFINITY; int bi = 0;
#pragma unroll
                for (int n = 0; n < 7; ++n) if (n < cb && !((selmask >> n) & 1u) && bs[n] > best) { best = bs[n]; bi = n; }
                selmask |= 1u << bi; } }
        unsigned um = selmask; um |= __shfl_xor(um, 1); um |= __shfl_xor(um, 2); um |= __shfl_xor(um, 4); um |= __shfl_xor(um, 8);
        if (lane == 0) list[48 + w] = (int)um;
        __syncthreads();
    }
    if (tid == 0) { int n = 0;
        if constexpr (SOFTMAX) { unsigned um = 0u; for (int i = 0; i < 8; ++i) um |= (unsigned)list[48 + i];
            for (int k = cb * 256; k < t0 + 128; k += 64) list[1 + n++] = k;
            for (int nb = 0; nb < cb; ++nb) if ((um >> nb) & 1u) for (int k = 0; k < 256; k += 64) list[1 + n++] = nb * 256 + k; }
        else { for (int k = 0; k < t0 + 128; k += 64) list[1 + n++] = k; }
        list[0] = n; }
    __syncthreads();
    const int cnt = list[0];

    f32x4 O[NT];
#pragma unroll
    for (int t = 0; t < NT; ++t) O[t] = (f32x4){0.f, 0.f, 0.f, 0.f};
    float m_run = -1e30f, l_run = 0.f;
    u32x4 kreg[NKC], v0r[NVC], v1r[NVC];
    const bf16_t* Kh = Kg + rowbase * 1024 + h * DK; const bf16_t* Vh = Vg + rowbase * 1024 + h * DV;
#define ATT_LOAD(k0_) do { const int k0__ = (k0_); _Pragma("unroll") for (int i = 0; i < NKC; ++i) { const int q = tid + 512 * i, row = q / (DK / 8), cc = q % (DK / 8); \
            kreg[i] = *(const u32x4*)(Kh + (size_t)(k0__ + row) * 1024 + 8 * cc); } \
        _Pragma("unroll") for (int i = 0; i < NVC; ++i) { const int q = tid + 512 * i, jp = q & 31, cc = q >> 5; \
            v0r[i] = *(const u32x4*)(Vh + (size_t)(k0__ + 2 * jp) * 1024 + 8 * cc); v1r[i] = *(const u32x4*)(Vh + (size_t)(k0__ + 2 * jp + 1) * 1024 + 8 * cc); } } while (0)
    ATT_LOAD(list[1]);
    const int kbase = KS_OFF + (8 * (c >> 2) + (c & 3)) * KST + 16 * kq, vbase = VT_OFF + c * VST + 16 * kq;
    for (int it = 0; it < cnt; ++it) {
        const int k0 = list[1 + it];
        __syncthreads();
#pragma unroll
        for (int i = 0; i < NKC; ++i) { const int q = tid + 512 * i, row = q / (DK / 8), cc = q % (DK / 8); *(LAS u32x4*)(lds + KS_OFF + row * KST + cc * 16) = kreg[i]; }
#pragma unroll
        for (int i = 0; i < NVC; ++i) { const int q = tid + 512 * i, jp = q & 31, cc = q >> 5;
#pragma unroll
            for (int e2 = 0; e2 < 4; ++e2) { const unsigned a = v0r[i][e2], bb = v1r[i][e2];
                *(LAS unsigned*)(lds + VT_OFF + (8 * cc + 2 * e2) * VST + jp * 4) = (a & 0xffffu) | (bb << 16);
                *(LAS unsigned*)(lds + VT_OFF + (8 * cc + 2 * e2 + 1) * VST + jp * 4) = (a >> 16) | (bb & 0xffff0000u); } }
        __syncthreads();
        if (it + 1 < cnt) ATT_LOAD(list[2 + it]);
        f32x4 S[4];
#pragma unroll
        for (int T = 0; T < 4; ++T) S[T] = (f32x4){0.f, 0.f, 0.f, 0.f};
#pragma unroll
        for (int s = 0; s < NS; ++s)
#pragma unroll
            for (int T = 0; T < 4; ++T) { const bf16x8 a = *(const LAS bf16x8*)(lds + kbase + (32 * (T >> 1) + 4 * (T & 1)) * KST + 64 * s);
                S[T] = __builtin_amdgcn_mfma_f32_16x16x32_bf16(a, bq[s], S[T], 0, 0, 0); }
        if constexpr (SOFTMAX) {
            const int nb = k0 >> 8; const bool own = nb == cb, rowsel = (selmask >> nb) & 1u; float tmax = -1e30f;
#pragma unroll
            for (int T = 0; T < 4; ++T)
#pragma unroll
                for (int jj = 0; jj < 4; ++jj) { const int j = k0 + 32 * (T >> 1) + 8 * kq + 4 * (T & 1) + jj; const bool ok = own ? (j <= qi) : rowsel;
                    S[T][jj] = ok ? S[T][jj] : -1e30f; tmax = fmaxf(tmax, S[T][jj]); }
            tmax = fmaxf(tmax, __shfl_xor(tmax, 16)); tmax = fmaxf(tmax, __shfl_xor(tmax, 32));
            const float m_new = fmaxf(m_run, tmax), alpha = ex2(m_run - m_new); m_run = m_new; float ps = 0.f;
#pragma unroll
            for (int T = 0; T < 4; ++T)
#pragma unroll
                for (int jj = 0; jj < 4; ++jj) { S[T][jj] = ex2(S[T][jj] - m_new); ps += S[T][jj]; }
            l_run = l_run * alpha + ps;
#pragma unroll
            for (int t = 0; t < NT; ++t) O[t] *= alpha;
        } else {
#pragma unroll
            for (int T = 0; T < 4; ++T)
#pragma unroll
                for (int jj = 0; jj < 4; ++jj) { const int d = qi - (k0 + 32 * (T >> 1) + 8 * kq + 4 * (T & 1) + jj);
                    S[T][jj] = d >= 0 ? S[T][jj] * ex2(log2g * (float)d) : 0.f; }
        }
        bf16x8 pb[2];
#pragma unroll
        for (int sp = 0; sp < 2; ++sp) { u32x4 pw; pw.x = pkbf(S[2 * sp][0], S[2 * sp][1]); pw.y = pkbf(S[2 * sp][2], S[2 * sp][3]);
            pw.z = pkbf(S[2 * sp + 1][0], S[2 * sp + 1][1]); pw.w = pkbf(S[2 * sp + 1][2], S[2 * sp + 1][3]); pb[sp] = __builtin_bit_cast(bf16x8, pw); }
#pragma unroll
        for (int t = 0; t < NT; ++t)
#pragma unroll
            for (int sp = 0; sp < 2; ++sp) { const bf16x8 a = *(const LAS bf16x8*)(lds + vbase + 16 * t * VST + 64 * sp);
                O[t] = __builtin_amdgcn_mfma_f32_16x16x32_bf16(a, pb[sp], O[t], 0, 0, 0); }
    }
#undef ATT_LOAD
    const size_t orow = (rowbase + qi) * 1024 + h * DV + 4 * kq;
    if constexpr (SOFTMAX) {
        float l = l_run; l += __shfl_xor(l, 16); l += __shfl_xor(l, 32); const float inv = 1.f / l;
#pragma unroll
        for (int t = 0; t < NT; ++t) st4(Og + orow + 16 * t, O[t] * inv);
    } else {
        if (qt == 0 && w == 0) {
            float qa[4][4], ka[4][4];
#pragma unroll
            for (int tk = 0; tk < 4; ++tk) { const float* q0 = qk0 + ((size_t)tk * 8 + b) * 2048 + h * 256 + 2 * lane;
                const float c0 = trc[tk * 128 + 2 * lane], c1 = trc[tk * 128 + 2 * lane + 1], s0 = trs[tk * 128 + 2 * lane], s1 = trs[tk * 128 + 2 * lane + 1];
                const float q1a = q0[0], q1b = q0[1], q2a = q0[128], q2b = q0[129], k1a = q0[1024], k1b = q0[1025], k2a = q0[1152], k2b = q0[1153];
                qa[tk][0] = q1a * c0 - q2a * s0; qa[tk][1] = q1b * c1 - q2b * s1; qa[tk][2] = q2a * c0 + q1a * s0; qa[tk][3] = q2b * c1 + q1b * s1;
                ka[tk][0] = k1a * c0 - k2a * s0; ka[tk][1] = k1b * c1 - k2b * s1; ka[tk][2] = k2a * c0 + k1a * s0; ka[tk][3] = k2b * c1 + k1b * s1; }
            float cf[4] = {0.f, 0.f, 0.f, 0.f};
#pragma unroll
            for (int tk = 0; tk < 4; ++tk)
#pragma unroll
                for (int j = 0; j <= tk; ++j) { const float sc = wave_sum((qa[tk][0] * ka[j][0] + qa[tk][1] * ka[j][1]) + (qa[tk][2] * ka[j][2] + qa[tk][3] * ka[j][3])) * 0.0625f * ex2(log2g * (float)(tk - j));
                    if (c == tk) cf[j] = sc; }
            if (c < 4) {
#pragma unroll
                for (int t = 0; t < NT; ++t) { f32x4 o = {0.f, 0.f, 0.f, 0.f};
#pragma unroll
                    for (int j = 0; j < 4; ++j) { const u32x2 v = *(const u32x2*)(Vg + (rowbase + j) * 1024 + h * DV + 4 * kq + 16 * t);
                        o[0] += cf[j] * bflo(v.x); o[1] += cf[j] * bfhi(v.x); o[2] += cf[j] * bflo(v.y); o[3] += cf[j] * bfhi(v.y); }
                    O[t] = o; } } }
        float ss = 0.f;
#pragma unroll
        for (int t = 0; t < NT; ++t) ss += (O[t][0] * O[t][0] + O[t][1] * O[t][1]) + (O[t][2] * O[t][2] + O[t][3] * O[t][3]);
        ss += __shfl_xor(ss, 16); ss += __shfl_xor(ss, 32);
        const float rn = 1.f / sqrtf(ss * (1.f / DV) + EPS);
#pragma unroll
        for (int t = 0; t < NT; ++t) { const f32x4 wv = *(const f32x4*)(normw + h * DV + 4 * kq + 16 * t); const u32x2 g = *(const u32x2*)(rgate + orow + 16 * t);
            f32x4 o = O[t] * rn * wv; o[0] *= bflo(g.x); o[1] *= bfhi(g.x); o[2] *= bflo(g.y); o[3] *= bfhi(g.y);
            st4(Og + orow + 16 * t, o); }
    }
}

__device__ __forceinline__ void p0_transpose_item(const float* W, int K, int N, bf16_t* WT, const float* kscale, LAS float* scr, int item, int lane, bool ffn_perm = false) {
    const int nblk = N / 32, kb = item / nblk, nb = item % nblk, k0 = 64 * kb, n0 = 32 * nb;
    const int r0 = !ffn_perm ? n0 : (n0 < DFF ? (n0 >> 7) * 256 + (n0 & 127) : ((n0 - DFF) >> 7) * 256 + 128 + ((n0 - DFF) & 127));
    { const int kr = lane >> 3, nc = lane & 7; f32x4 v[8];
#pragma unroll
      for (int i = 0; i < 8; ++i) v[i] = *(const f32x4*)(W + (size_t)(k0 + 8 * i + kr) * N + n0 + 4 * nc);
#pragma unroll
      for (int i = 0; i < 8; ++i) { const int kk = 8 * i + kr; f32x4 t = v[i]; if (kscale) t *= kscale[k0 + kk]; LAS float* d = scr + kk * 33 + 4 * nc; d[0] = t[0]; d[1] = t[1]; d[2] = t[2]; d[3] = t[3]; } }
    asm volatile("s_waitcnt lgkmcnt(0)" ::: "memory");
    const int c = lane & 7;
#pragma unroll
    for (int j = 0; j < 4; ++j) { const int n = (lane >> 3) + 8 * j; const LAS float* s = scr + (8 * c) * 33 + n;
        u32x4 o; o.x = pkbf(s[0 * 33], s[1 * 33]); o.y = pkbf(s[2 * 33], s[3 * 33]); o.z = pkbf(s[4 * 33], s[5 * 33]); o.w = pkbf(s[6 * 33], s[7 * 33]);
        *(u32x4*)(WT + (size_t)(r0 + n) * K + k0 + 8 * c) = o; }
    asm volatile("s_waitcnt lgkmcnt(0)" ::: "memory");
}

struct TrItem { const float* W; bf16_t* WT; const float* kscale; int K, N, item, perm; };
__device__ __forceinline__ void p0_tr_load(const TrItem& d, int lane, f32x4 (&v)[8]) {
    const int nblk = d.N / 32, kb = d.item / nblk, nb = d.item % nblk, k0 = 64 * kb, n0 = 32 * nb, kr = lane >> 3, nc = lane & 7;
#pragma unroll
    for (int i = 0; i < 8; ++i) v[i] = *(const f32x4*)(d.W + (size_t)(k0 + 8 * i + kr) * d.N + n0 + 4 * nc);
}
__device__ __forceinline__ void p0_tr_finish(const TrItem& d, int lane, const f32x4 (&v)[8], LAS float* scr) {
    const int nblk = d.N / 32, kb = d.item / nblk, nb = d.item % nblk, k0 = 64 * kb, n0 = 32 * nb, kr = lane >> 3, nc = lane & 7;
    const int r0 = !d.perm ? n0 : (n0 < DFF ? (n0 >> 7) * 256 + (n0 & 127) : ((n0 - DFF) >> 7) * 256 + 128 + ((n0 - DFF) & 127));
#pragma unroll
    for (int i = 0; i < 8; ++i) { const int kk = 8 * i + kr; f32x4 t = v[i]; if (d.kscale) t *= d.kscale[k0 + kk]; LAS float* q = scr + kk * 33 + 4 * nc; q[0] = t[0]; q[1] = t[1]; q[2] = t[2]; q[3] = t[3]; }
    asm volatile("s_waitcnt lgkmcnt(0)" ::: "memory");
    const int c = lane & 7;
#pragma unroll
    for (int j = 0; j < 4; ++j) { const int n = (lane >> 3) + 8 * j; const LAS float* s = scr + (8 * c) * 33 + n;
        u32x4 o; o.x = pkbf(s[0 * 33], s[1 * 33]); o.y = pkbf(s[2 * 33], s[3 * 33]); o.z = pkbf(s[4 * 33], s[5 * 33]); o.w = pkbf(s[6 * 33], s[7 * 33]);
        *(u32x4*)(d.WT + (size_t)(r0 + n) * d.K + k0 + 8 * c) = o; }
    asm volatile("s_waitcnt lgkmcnt(0)" ::: "memory");
}
#define RLX_AGENT __ATOMIC_RELAXED, __HIP_MEMORY_SCOPE_AGENT
#define XB_TMO      128
#define XB_XCNT(j)  (256  + 64 * (j))
#define XB_XSUB(j)  (1280 + 64 * (j))
#define XB_XGEN(j)  (2304 + 64 * (j))
#define XB_TOP      3328
#define XB_TOPGEN   3392
#define XCD_BAR_WORDS 3456
#define XB_SPIN_CAP (1u << 18)

__device__ __forceinline__ unsigned xb_ld(unsigned* p)              { return __hip_atomic_load(p, __ATOMIC_RELAXED, __HIP_MEMORY_SCOPE_AGENT); }
__device__ __forceinline__ unsigned xb_add(unsigned* p, unsigned v) { return __hip_atomic_fetch_add(p, v, __ATOMIC_RELAXED, __HIP_MEMORY_SCOPE_AGENT); }
__device__ __forceinline__ unsigned xb_xcc_id() { return (unsigned)__builtin_amdgcn_s_getreg((3 << 11) | 20) & 0xFu; }
#define XB_SPIN(cond, bar) do { unsigned _sp = 0; while (cond) { __builtin_amdgcn_s_sleep(1); \
    if ((++_sp & 255u) == 0u) { if (xb_ld(&(bar)[XB_TMO])) break; if (_sp > XB_SPIN_CAP) { atomicAdd(&(bar)[XB_TMO], 1u); break; } } } } while (0)

struct XcdBarrier {
    unsigned* bar; unsigned x;
    volatile LAS unsigned* st;
};

__device__ __forceinline__ XcdBarrier xcd_barrier_post(unsigned* bar, volatile LAS unsigned* st) {
    XcdBarrier b; b.bar = bar; b.x = xb_xcc_id(); b.st = st;
    if (threadIdx.x == 0) (void)xb_add(&bar[XB_XCNT(b.x)], 1u);
    return b;
}
__device__ __forceinline__ void xcd_barrier_complete(unsigned* bar, unsigned x, unsigned& nloc, unsigned& nx) {
    const unsigned G = gridDim.x * gridDim.y * gridDim.z;
    unsigned sum, cnt, mine, sp = 0u;
    for (;;) {
        sum = 0u; cnt = 0u; mine = 0u;
#pragma unroll
        for (unsigned j = 0; j < 16; ++j) { const unsigned c = xb_ld(&bar[XB_XCNT(j)]); sum += c; cnt += (c > 0u) ? 1u : 0u; mine = (j == x) ? c : mine; }
        if (sum == G) break;
        __builtin_amdgcn_s_sleep(1);
        if ((++sp & 255u) == 0u) { if (xb_ld(&bar[XB_TMO])) break; if (sp > XB_SPIN_CAP) { atomicAdd(&bar[XB_TMO], 1u); break; } }
    }
    nloc = mine > 0u ? mine : 1u; nx = cnt > 0u ? cnt : 1u;
}

__device__ __forceinline__ void xcd_barrier(const XcdBarrier& b) {
    asm volatile("s_waitcnt vmcnt(0)" ::: "memory");
    __syncthreads();
    if (threadIdx.x == 0) {
        unsigned* bar = b.bar;
        __builtin_amdgcn_s_waitcnt(0);
        unsigned nloc = b.st[0], nx = b.st[1];
        if (nloc == 0u) { xcd_barrier_complete(bar, b.x, nloc, nx); b.st[0] = nloc; b.st[1] = nx; }
        const unsigned old = xb_add(&bar[XB_XSUB(b.x)], 1u);
        const unsigned gen = old / nloc;
        if (old + 1u == (gen + 1u) * nloc) {
            __builtin_amdgcn_fence(__ATOMIC_RELEASE, "agent");
            asm volatile("s_waitcnt vmcnt(0)" ::: "memory");
            const unsigned og = xb_add(&bar[XB_TOP], 1u);
            const unsigned tg = og / nx;
            if (og + 1u == (tg + 1u) * nx) xb_add(&bar[XB_TOPGEN], 1u);
            else XB_SPIN(xb_ld(&bar[XB_TOPGEN]) == tg, bar);
            __builtin_amdgcn_fence(__ATOMIC_ACQUIRE, "agent");
            xb_add(&bar[XB_XGEN(b.x)], 1u);
            asm volatile("s_waitcnt vmcnt(0)" ::: "memory");
        } else {
            XB_SPIN(xb_ld(&bar[XB_XGEN(b.x)]) == gen, bar);
            __builtin_amdgcn_fence(__ATOMIC_ACQUIRE, "agent");
            asm volatile("s_waitcnt vmcnt(0)" ::: "memory");
        }
    }
    __syncthreads();
}

struct Args { const float* in[13]; float* out; unsigned char* ws; };

__device__ __forceinline__ const __attribute__((address_space(4))) Args* kargs() { const __attribute__((address_space(4))) Args* p = (const __attribute__((address_space(4))) Args*)__builtin_amdgcn_kernarg_segment_ptr(); asm volatile("" : "+s"(p)); return p; }
#ifndef PROBE_SYNCN
#define PROBE_SYNCN 1
#endif
#define GRID_SYNC() for (int gs_ = 0; gs_ < PROBE_SYNCN; ++gs_) do { asm volatile("s_waitcnt vmcnt(0) lgkmcnt(0)" ::: "memory"); grid.sync(); asm volatile("s_waitcnt vmcnt(0)" ::: "memory"); __builtin_amdgcn_s_barrier(); asm volatile("" ::: "memory"); } while (0)
#define XSYNC() do { XcdBarrier xb_; xb_.bar = (unsigned*)(kargs()->ws + WS_XBAR); xb_.x = xb_xcc_id(); xb_.st = (volatile LAS unsigned*)(lds + XB_ST_OFF); xcd_barrier(xb_); } while (0)
#define PV \
    const __attribute__((address_space(4))) Args* ap = kargs(); \
    int tid = threadIdx.x; asm volatile("" : "+v"(tid)); \
    const int lane = tid & 63, wave = __builtin_amdgcn_readfirstlane(tid >> 6); \
    const int G = gridDim.x, bx = blockIdx.x; \
    unsigned char* ws = ap->ws; \
    const float* x = ap->in[0]; const float* attn_norm_w = ap->in[1]; const float* w_in = ap->in[2]; const float* ret_norm_w = ap->in[3]; \
    const float* w_ret_up = ap->in[4]; const float* w_moba_up = ap->in[5]; const float* w_out = ap->in[6]; const float* ffn_norm_w = ap->in[7]; \
    const float* w_ffn_up = ap->in[8]; const float* conv_w = ap->in[9]; const float* conv_b = ap->in[10]; const float* w_ffn_down = ap->in[11]; \
    const float* final_norm_w = ap->in[12]; \
    float* out = ap->out; \
    float* rowss1 = (float*)(ws + WS_RSS1); float* rowss2 = (float*)(ws + WS_RSS2); float* kmean = (float*)(ws + WS_KMEAN); \
    float* qk0 = (float*)(ws + WS_QK0); float* tmc = (float*)(ws + WS_TMC); float* tms = (float*)(ws + WS_TMS); float* trc = (float*)(ws + WS_TRC); float* trs = (float*)(ws + WS_TRS); \
    bf16_t* Win_t = (bf16_t*)(ws + WS_WIN); bf16_t* Wup_t = (bf16_t*)(ws + WS_WUP); bf16_t* Wdn_t = (bf16_t*)(ws + WS_WDN); \
    bf16_t* Wout_t = (bf16_t*)(ws + WS_WOUT); bf16_t* Wru_t = (bf16_t*)(ws + WS_WRU); bf16_t* Wmu_t = (bf16_t*)(ws + WS_WMU); \
    bf16_t* SEC = (bf16_t*)(ws + WS_SEC); bf16_t* GR = (bf16_t*)(ws + WS_GR); bf16_t* GM = (bf16_t*)(ws + WS_GM); \
    bf16_t* T1 = (bf16_t*)(ws + WS_T1); bf16_t* MERGED = (bf16_t*)(ws + WS_MERGED); bf16_t* X1B = (bf16_t*)(ws + WS_X1B); \
    bf16_t* UH = (bf16_t*)(ws + WS_UH); bf16_t* GH = (bf16_t*)(ws + WS_GH); bf16_t* GF = (bf16_t*)(ws + WS_GF); float* H1 = (float*)(ws + WS_H1); float* H2 = (float*)(ws + WS_H2); \
    bf16_t* Hb = (bf16_t*)out; \
    bf16_t* OMOBA = (bf16_t*)out; \
    bf16_t* ORET = (bf16_t*)out + SEC_ELEMS; \
    const int gw = bx * 8 + wave, NGW = G * 8, gt = bx * 512 + tid, NGT = G * 512;
__global__ void __launch_bounds__(512, 2) fwd_megakernel(Args args) {
    extern __shared__ __attribute__((aligned(16))) unsigned char lds_raw[];
    LAS unsigned char* lds = (LAS unsigned char*)lds_raw;
    cg::grid_group grid = cg::this_grid();
    if (threadIdx.x < 2) ((volatile LAS unsigned*)(lds + XB_ST_OFF))[threadIdx.x] = 0u;
    __syncthreads();
#ifndef SKIP_P0
    { PV;
#ifdef PROBE_P0X2
    for (int rep0_ = 0; rep0_ < 2; ++rep0_)
#endif
    {
        for (int i = gt; i < SEQ * 128; i += NGT) { const int pos = i >> 7, k = i & 127; const float inv = powf(10000.0f, -(float)(2 * k) / 256.0f), ang = (float)pos * inv;
            trc[i] = cosf(ang); trs[i] = sinf(ang); }
        for (int i = gt; i < SEQ * 16; i += NGT) { const int pos = i >> 4, k = i & 15; const float inv = powf(500000.0f, -(float)(2 * k) / 32.0f), ang = (float)pos * inv;
            tmc[i] = cosf(ang); tms[i] = sinf(ang); }
        for (int i = gt; i < XCD_BAR_WORDS; i += NGT) ((unsigned*)(ws + WS_XBAR))[i] = 0u;
        LAS float* scr = (LAS float*)(lds + wave * 16384);
        constexpr int I_IN = (DM / 64) * (NIN / 32), I_UP = I_IN, I_DN = (DFF / 64) * (DM / 32), I_OUT = (DM / 64) * (DM / 32), I_RU = (1024 / 64) * (DM / 32);
        constexpr int NITEMS = I_IN + I_UP + I_DN + I_OUT + 2 * I_RU;
#define P0_DECODE(d_, it_) do { int r = (it_); \
            if (r < I_IN) { d_ = TrItem{w_in, Win_t, nullptr, DM, NIN, r, 0}; break; } r -= I_IN; \
            if (r < I_UP) { d_ = TrItem{w_ffn_up, Wup_t, ffn_norm_w, DM, NFF, r, FUSED_FFN != 0}; break; } r -= I_UP; \
            if (r < I_DN) { d_ = TrItem{w_ffn_down, Wdn_t, nullptr, DFF, DM, r, 0}; break; } r -= I_DN; \
            if (r < I_OUT) { d_ = TrItem{w_out, Wout_t, nullptr, DM, DM, r, 0}; break; } r -= I_OUT; \
            if (r < I_RU) { d_ = TrItem{w_ret_up, Wru_t, nullptr, 1024, DM, r, 0}; break; } r -= I_RU; \
            d_ = TrItem{w_moba_up, Wmu_t, nullptr, 1024, DM, r, 0}; } while (0)
        for (int it = gw; it < NITEMS; it += 2 * NGW) { TrItem d0, d1; f32x4 v0[8], v1[8];
            P0_DECODE(d0, it); p0_tr_load(d0, lane, v0);
            const bool has1 = it + NGW < NITEMS;
            if (has1) { P0_DECODE(d1, it + NGW); p0_tr_load(d1, lane, v1); }
            p0_tr_finish(d0, lane, v0, scr);
            if (has1) p0_tr_finish(d1, lane, v1, scr); }
#undef P0_DECODE
        for (int m = gw; m < MTOK; m += NGW) {
            const f32x4* xr = (const f32x4*)(x + (size_t)m * DM) + lane; const f32x4* wr4 = (const f32x4*)attn_norm_w + lane;
            f32x4 v[8]; float s = 0.f;
#pragma unroll
            for (int j = 0; j < 8; ++j) { v[j] = xr[64 * j]; s += (v[j][0] * v[j][0] + v[j][1] * v[j][1]) + (v[j][2] * v[j][2] + v[j][3] * v[j][3]); }
            const float r = 1.f / sqrtf(wave_sum(s) * (1.f / DM) + EPS);
            u32x2* o8 = (u32x2*)(Hb + (size_t)m * DM) + lane;
#pragma unroll
            for (int j = 0; j < 8; ++j) { const f32x4 wv = wr4[64 * j]; u32x2 o; o.x = pkbf(v[j][0] * r * wv[0], v[j][1] * r * wv[1]); o.y = pkbf(v[j][2] * r * wv[2], v[j][3] * r * wv[3]); o8[64 * j] = o; } }
        __syncthreads();
      for (int it0 = bx; it0 < 32 * 4; it0 += G) { const int it = it0 & 31, tk = it0 >> 5; LAS float* hrow = (LAS float*)lds; LAS float* red = (LAS float*)(lds + 65536);
          { const f32x4* xr = (const f32x4*)(x + ((size_t)wave * SEQ + tk) * DM) + lane; const f32x4* wr4 = (const f32x4*)attn_norm_w + lane; f32x4 v[8]; float sq = 0.f;
#pragma unroll
            for (int j = 0; j < 8; ++j) { v[j] = xr[64 * j]; sq += (v[j][0] * v[j][0] + v[j][1] * v[j][1]) + (v[j][2] * v[j][2] + v[j][3] * v[j][3]); }
            const float r = 1.f / sqrtf(wave_sum(sq) * (1.f / DM) + EPS);
#pragma unroll
            for (int j = 0; j < 8; ++j) { const f32x4 wv = wr4[64 * j]; *(LAS f32x4*)(hrow + wave * 2048 + 4 * (lane + 64 * j)) = v[j] * r * wv; } }
          __syncthreads();
          const int col = tid & 63, kp = tid >> 6; const float* wp = w_in + (size_t)(kp * 256) * NIN + it * 64 + col; float a[8] = {0.f, 0.f, 0.f, 0.f, 0.f, 0.f, 0.f, 0.f};
#pragma unroll 16
          for (int k = 0; k < 256; ++k) { const float wv = wp[(size_t)k * NIN];
#pragma unroll
              for (int bb = 0; bb < 8; ++bb) a[bb] += hrow[bb * 2048 + kp * 256 + k] * wv; }
#pragma unroll
          for (int bb = 0; bb < 8; ++bb) red[(kp * 8 + bb) * 64 + col] = a[bb];
          __syncthreads();
          { const int bb = tid >> 6; float sacc = 0.f;
#pragma unroll
            for (int p = 0; p < 8; ++p) sacc += red[(p * 8 + bb) * 64 + col];
            qk0[((size_t)tk * 8 + bb) * 2048 + it * 64 + col] = sacc; }
          __syncthreads(); }
    }
    GRID_SYNC();
    { volatile LAS unsigned* st_ = (volatile LAS unsigned*)(lds + XB_ST_OFF); (void)xcd_barrier_post((unsigned*)(kargs()->ws + WS_XBAR), st_); }

    }
#endif
#ifdef PROBE_TABLES
    { PV;
      for (size_t i = gt; i < (size_t)MTOK * DM; i += NGT) { out[i] = trc[i & 262143] + 2.f * trs[i & 262143] + 4.f * tmc[i & 32767] + 8.f * tms[i & 32767]; }
      return; }
#endif
#ifdef PROBE_AFTER_P0
    { PV; const bf16_t* P = Win_t; const size_t NW = (size_t)63 * 1024 * 1024;
      for (size_t i = gt; i < (size_t)MTOK * DM; i += NGT) { float a = bflo((unsigned)P[i]); if (i + (size_t)MTOK * DM < NW) a += bflo((unsigned)P[i + (size_t)MTOK * DM]); out[i] = a; }
      return; }
#endif
#ifndef SKIP_P1
    { PV;
    { pg8::Gemm g{Hb, Win_t, MTOK, NIN, DM}; pg8::StaticOrder S; S.init(MTOK, NIN, G, bx);
#ifdef PROBE_PLAIN
      pg8::EpiPlain E{SEC, NIN};
      pg8::gemm_phase<pg8::EpiPlain, pg8::StaticOrder, GEMM_ALIGN, GEMM_SP2>(lds, g, S, E); }
#else
      pg8::EpiProj E{SEC, GR, GM, trc, trs, tmc, tms, kmean};
      pg8::gemm_phase<pg8::EpiProj, pg8::StaticOrder, GEMM_ALIGN, GEMM_SP2>(lds, g, S, E); }
#endif
    XSYNC();

    }
#endif
#ifdef PROBE_AFTER_P1
    { PV; const bf16_t* P = SEC;
      for (size_t i = gt; i < (size_t)MTOK * DM; i += NGT) { float a = 0.f; for (int j = 0; j < 11; ++j) a += bflo((unsigned)P[(size_t)j * SEC_ELEMS + (i & (SEC_ELEMS - 1))]); out[i] = a; }
      return; }
#endif
#ifndef SKIP_P2
    { PV;
#ifdef PROBE_P2X2
    for (int rep_ = 0; rep_ < 2; ++rep_)
#endif
    for (int u = bx; u < 256 + 512; u += G) {
        if (u < 256) { const int bh = u >> 3, j = u & 7, b = bh >> 2, h = bh & 3;
            const float log2g = log2f(1.0f - exp2f(-5.0f - (float)h));
            attn_unit<256, 256, false>(lds, SEC, SEC + SEC_ELEMS, SEC + 2 * SEC_ELEMS, ORET, b, h, 15 - j, ret_norm_w, SEC + 3 * SEC_ELEMS, log2g, nullptr, qk0, trc, trs);
            attn_unit<256, 256, false>(lds, SEC, SEC + SEC_ELEMS, SEC + 2 * SEC_ELEMS, ORET, b, h, j, ret_norm_w, SEC + 3 * SEC_ELEMS, log2g, nullptr, qk0, trc, trs);
        } else { const int v = u - 256, bh = v >> 3, j = v & 7, b = bh >> 3, h = bh & 7;
            attn_unit<128, 128, true>(lds, SEC + 4 * SEC_ELEMS, SEC + 5 * SEC_ELEMS, SEC + 6 * SEC_ELEMS, OMOBA, b, h, 15 - j, nullptr, nullptr, 0.f, kmean, nullptr, nullptr, nullptr);
            attn_unit<128, 128, true>(lds, SEC + 4 * SEC_ELEMS, SEC + 5 * SEC_ELEMS, SEC + 6 * SEC_ELEMS, OMOBA, b, h, j, nullptr, nullptr, 0.f, kmean, nullptr, nullptr, nullptr);
        }
    }
    __syncthreads();
    XSYNC();

    }
#endif
#ifndef SKIP_P3
    { PV;
    { pg8::Gemm g{OMOBA, Wru_t, 2 * MTOK, 2 * DM, 1024}; pg8::PairOrder S; S.init(MTOK, DM, G, bx); pg8::EpiGate2 E{GR, GM, MERGED};
      pg8::gemm_phase<pg8::EpiGate2, pg8::PairOrder, GEMM_ALIGN, GEMM_SP2>(lds, g, S, E); }
    XSYNC();

    }
#endif
#ifndef SKIP_P4
    { PV;
    { pg8::Gemm g{MERGED, Wout_t, MTOK, DM, DM}; pg8::StaticOrder S; S.init(MTOK, DM, G, bx); pg8::EpiRes E{x, out, X1B, rowss1};
      pg8::gemm_phase<pg8::EpiRes, pg8::StaticOrder, GEMM_ALIGN, GEMM_SP2>(lds, g, S, E); }
    XSYNC();

    }
#endif
#ifndef SKIP_FFN
#ifdef PROBE_AFTER_P4
    return;
#endif
#if FUSED_FFN
    { PV;
      { pg8::Gemm g{X1B, Wup_t, MTOK, NFF, DM}; pg8::StaticOrder S; S.init(MTOK, NFF, G, bx); pg8::EpiConv E{GF, rowss1, conv_w, conv_b, H1, H2, lds + 131072};
        pg8::gemm_phase<pg8::EpiConv, pg8::StaticOrder, true, GEMM_SP2>(lds, g, S, E); }
    }
    XSYNC();
    { PV;
      for (int it = gt; it < 56 * 44 * 16; it += NGT) { const int i8 = it & 15, j = (it >> 4) % 44, q = (it >> 4) / 44, pm = q + q / 7 + 1;
          const int ca = j * 256 + 8 * i8, ch = j * 128 + 8 * i8;
          const float* pA = H1 + (size_t)((pm - 1) * 2) * NFF; const float* pB = pA + NFF; const float* c0 = H2 + (size_t)(pm * 2) * NFF; const float* c1 = c0 + NFF;
#pragma unroll
          for (int hh = 0; hh < 2; ++hh) { const int ta = ca + 4 * hh, tb = ta + 128, cc = ch + 4 * hh;
              const f32x4 wa0 = *(const f32x4*)(conv_w + cc), wa1 = *(const f32x4*)(conv_w + NFF + cc), wa2 = *(const f32x4*)(conv_w + 2 * NFF + cc);
              const f32x4 wb0 = *(const f32x4*)(conv_w + DFF + cc), wb1 = *(const f32x4*)(conv_w + NFF + DFF + cc), wb2 = *(const f32x4*)(conv_w + 2 * NFF + DFF + cc);
              const f32x4 ba = *(const f32x4*)(conv_b + cc), bb = *(const f32x4*)(conv_b + DFF + cc);
              const f32x4 aA = *(const f32x4*)(pA + ta), aB = *(const f32x4*)(pB + ta), a0 = *(const f32x4*)(c0 + ta), a1 = *(const f32x4*)(c1 + ta);
              const f32x4 bA = *(const f32x4*)(pA + tb), bB = *(const f32x4*)(pB + tb), b0 = *(const f32x4*)(c0 + tb), b1 = *(const f32x4*)(c1 + tb);
              const f32x4 ya0 = ba + wa0 * aA + wa1 * aB + wa2 * a0, yb0 = bb + wb0 * bA + wb1 * bB + wb2 * b0;
              const f32x4 ya1 = ba + wa0 * aB + wa1 * a0 + wa2 * a1, yb1 = bb + wb0 * bB + wb1 * b0 + wb2 * b1;
              f32x4 g0, g1;
#pragma unroll
              for (int e = 0; e < 4; ++e) { g0[e] = ya0[e] * sigm(ya0[e]) * yb0[e]; g1[e] = ya1[e] * sigm(ya1[e]) * yb1[e]; }
              st4(GF + (size_t)(pm * 256) * DFF + cc, g0); st4(GF + (size_t)(pm * 256 + 1) * DFF + cc, g1); } }
    }
    XSYNC();
    { PV;
      { pg8::Gemm g{GF, Wdn_t, MTOK, DM, DFF}; pg8::StaticOrder S; S.init(MTOK, DM, G, bx); pg8::EpiRes E{out, out, nullptr, rowss2};
        pg8::gemm_phase<pg8::EpiRes, pg8::StaticOrder, GEMM_ALIGN, GEMM_SP2>(lds, g, S, E); }
    }
    XSYNC();
#else
    for (int half = 0; half < 2; ++half) {
#ifndef SKIP_FFN_UP
        { PV; const size_t r0 = (size_t)half * 8192;
        { pg8::Gemm g{X1B + r0 * DM, Wup_t, 8192, NFF, DM}; pg8::StaticOrder S; S.init(8192, NFF, G, bx); pg8::EpiUp E{UH, rowss1 + r0 * 32};
          pg8::gemm_phase<pg8::EpiUp, pg8::StaticOrder, GEMM_ALIGN, GEMM_SP2>(lds, g, S, E); }
        }
#endif
        XSYNC();
#ifndef SKIP_FFN_CONV
        { PV; const size_t r0 = (size_t)half * 8192;
        for (int it = gt; it < 512 * 704; it += NGT) { const int cg8 = it % 704, rc = it / 704, ch = cg8 * 8, lr0 = rc * 16;
            float wa[3][8], wb[3][8], ba[8], bb[8];
#pragma unroll
            for (int k = 0; k < 3; ++k)
#pragma unroll
                for (int e = 0; e < 8; ++e) { wa[k][e] = conv_w[k * NFF + ch + e]; wb[k][e] = conv_w[k * NFF + DFF + ch + e]; }
#pragma unroll
            for (int e = 0; e < 8; ++e) { ba[e] = conv_b[ch + e]; bb[e] = conv_b[DFF + ch + e]; }
            float a1[8], a2[8], b1[8], b2[8];
            const bool hasprev = (lr0 & (SEQ - 1)) != 0;
#pragma unroll
            for (int e = 0; e < 8; ++e) { a1[e] = 0.f; a2[e] = 0.f; b1[e] = 0.f; b2[e] = 0.f; }
            if (hasprev) { const u32x4 p2a = *(const u32x4*)(UH + (size_t)(lr0 - 2) * NFF + ch), p1a = *(const u32x4*)(UH + (size_t)(lr0 - 1) * NFF + ch);
                const u32x4 p2b = *(const u32x4*)(UH + (size_t)(lr0 - 2) * NFF + DFF + ch), p1b = *(const u32x4*)(UH + (size_t)(lr0 - 1) * NFF + DFF + ch);
#pragma unroll
                for (int e = 0; e < 4; ++e) { a2[2 * e] = bflo(p2a[e]); a2[2 * e + 1] = bfhi(p2a[e]); a1[2 * e] = bflo(p1a[e]); a1[2 * e + 1] = bfhi(p1a[e]);
                    b2[2 * e] = bflo(p2b[e]); b2[2 * e + 1] = bfhi(p2b[e]); b1[2 * e] = bflo(p1b[e]); b1[2 * e + 1] = bfhi(p1b[e]); } }
#pragma unroll 2
            for (int r = 0; r < 16; ++r) { const u32x4 ca = *(const u32x4*)(UH + (size_t)(lr0 + r) * NFF + ch), cbv = *(const u32x4*)(UH + (size_t)(lr0 + r) * NFF + DFF + ch);
                float a0[8], b0[8], gq[8];
#pragma unroll
                for (int e = 0; e < 4; ++e) { a0[2 * e] = bflo(ca[e]); a0[2 * e + 1] = bfhi(ca[e]); b0[2 * e] = bflo(cbv[e]); b0[2 * e + 1] = bfhi(cbv[e]); }
#pragma unroll
                for (int e = 0; e < 8; ++e) { const float ya = ba[e] + wa[0][e] * a2[e] + wa[1][e] * a1[e] + wa[2][e] * a0[e], yb = bb[e] + wb[0][e] * b2[e] + wb[1][e] * b1[e] + wb[2][e] * b0[e];
                    gq[e] = ya * sigm(ya) * yb; a2[e] = a1[e]; a1[e] = a0[e]; b2[e] = b1[e]; b1[e] = b0[e]; }
                u32x4 o; o.x = pkbf(gq[0], gq[1]); o.y = pkbf(gq[2], gq[3]); o.z = pkbf(gq[4], gq[5]); o.w = pkbf(gq[6], gq[7]);
                *(u32x4*)(GH + (size_t)(lr0 + r) * DFF + ch) = o; } }
        }
#endif
        XSYNC();
#ifndef SKIP_FFN_DN
        { PV; const size_t r0 = (size_t)half * 8192;
        { pg8::Gemm g{GH, Wdn_t, 8192, DM, DFF}; pg8::StaticOrder S; S.init(8192, DM, G, bx); pg8::EpiRes E{out + r0 * DM, out + r0 * DM, nullptr, rowss2 + r0 * 32};
          pg8::gemm_phase<pg8::EpiRes, pg8::StaticOrder, GEMM_ALIGN, GEMM_SP2>(lds, g, S, E); }
        }
#endif
        XSYNC();
    }
#endif

#endif
#ifndef SKIP_P8
    { PV;
    for (int m = gw; m < MTOK; m += NGW) {
        f32x4* xr = (f32x4*)(out + (size_t)m * DM) + lane; const f32x4* wr4 = (const f32x4*)final_norm_w + lane;
        const float r = 1.f / sqrtf(wave_sum(lane < 32 ? rowss2[(size_t)m * 32 + lane] : 0.f) * (1.f / DM) + EPS);
#pragma unroll
        for (int j = 0; j < 8; ++j) { const f32x4 v = xr[64 * j]; xr[64 * j] = v * r * wr4[64 * j]; }
    }
    }
#endif
}

extern "C" void kernel_launch(void* const* d_in, const int* in_sizes, int n_in, void* d_out, int out_size, void* d_ws, size_t ws_size, hipStream_t stream) {
    static int grid = 0;
    if (grid == 0) {
        if (n_in != 13 || in_sizes[0] != MTOK * DM || out_size != MTOK * DM || ws_size < WS_END) { fprintf(stderr, "kernel_launch: unexpected shapes (n_in %d, ws %zu)\n", n_in, ws_size); grid = -1; return; }
        int dev = 0, cus = 0, per_cu = 0;
        hipGetDevice(&dev); hipDeviceGetAttribute(&cus, hipDeviceAttributeMultiprocessorCount, dev);
        if (hipFuncSetAttribute((const void*)fwd_megakernel, hipFuncAttributeMaxDynamicSharedMemorySize, LDS_BYTES) != hipSuccess) { fprintf(stderr, "kernel_launch: hipFuncSetAttribute failed\n"); grid = -1; return; }
        if (hipOccupancyMaxActiveBlocksPerMultiprocessor(&per_cu, (const void*)fwd_megakernel, 512, LDS_BYTES) != hipSuccess || per_cu < 1) { fprintf(stderr, "kernel_launch: occupancy query gave %d\n", per_cu); grid = -1; return; }
        grid = cus * (per_cu > 1 ? 1 : per_cu);
    }
    if (grid < 0) return;
    Args a{};
    for (int i = 0; i < 13; ++i) a.in[i] = (const float*)d_in[i];
    a.out = (float*)d_out; a.ws = (unsigned char*)d_ws;
    void* kargs[] = {&a};
    hipError_t e = hipLaunchCooperativeKernel((const void*)fwd_megakernel, dim3(grid), dim3(512), kargs, LDS_BYTES, stream);
    if (e != hipSuccess) fprintf(stderr, "kernel_launch: cooperative launch failed: %s (grid %d)\n", hipGetErrorString(e), grid);
}
```
